# Optimizing an MI355X kernel written in HIP

```python
import math
import jax, jax.numpy as jnp
from jax import lax
import numpy as np

D_MODEL = 1024
BATCH = 8
SEQ = 2048
DEPTH = 1

HEAD_DIM = 64
ATTN_PAIRS = ((128, 1), (512, 4), (2048, 16))
HEADS_PER_GROUP = 4
N_ATTN_HEADS = HEADS_PER_GROUP * len(ATTN_PAIRS)
ATTN_WIDTH = N_ATTN_HEADS * HEAD_DIM
ATTN_OUT_WIDTH = HEADS_PER_GROUP * HEAD_DIM
GLA_HEADS = 4
GLA_DK = 64
GLA_DV = 128
GLA_K_WIDTH = GLA_HEADS * GLA_DK
GLA_V_WIDTH = GLA_HEADS * GLA_DV
GLA_RANK = 16
GLA_TAU = 16.0
GLA_CHUNK = 64
REL_BUCKETS = 32
REL_MAX_DISTANCE = 1024
D_FF = 4 * D_MODEL
ALPHA = (2 * DEPTH) ** 0.25
BETA = (8 * DEPTH) ** -0.25
LN_EPS = 1e-5
NORM_EPS = 1e-6
NEG_INF = -1e30

IN_SIZES = (ATTN_WIDTH, ATTN_WIDTH, ATTN_WIDTH,
            GLA_K_WIDTH, GLA_K_WIDTH, GLA_V_WIDTH, GLA_V_WIDTH,
            GLA_RANK, GLA_RANK, D_MODEL, D_MODEL)
IN_COLS = int(sum(IN_SIZES))
IN_SPLITS = tuple(int(c) for c in np.cumsum(IN_SIZES)[:-1])

kernel_name = "hybrid_dilated_attn_gla_sqrelu_deepnorm"


def _layernorm(x, g, b):
    xf = x.astype(jnp.float32)
    mu = jnp.mean(xf, axis=-1, keepdims=True)
    var = jnp.mean(jnp.square(xf - mu), axis=-1, keepdims=True)
    y = (xf - mu) * lax.rsqrt(var + LN_EPS) * g.astype(jnp.float32) + b.astype(jnp.float32)
    return y.astype(x.dtype)


def _t5_bucket(rel):
    nb = REL_BUCKETS // 2
    max_exact = nb // 2
    ret = (rel > 0).astype(np.int32) * nb
    n = np.abs(rel)
    large = max_exact + (np.log(np.maximum(n, 1) / max_exact)
                         / np.log(REL_MAX_DISTANCE / max_exact) * (nb - max_exact)).astype(np.int32)
    large = np.minimum(large, nb - 1)
    return (ret + np.where(n < max_exact, n, large)).astype(np.int32)


def _group_bias(rel_bias, group, dilation, blk):
    rel_sub = np.arange(3 * blk)[None, :] - blk - np.arange(blk)[:, None]
    bucket = _t5_bucket(rel_sub * dilation)
    heads = slice(group * HEADS_PER_GROUP, (group + 1) * HEADS_PER_GROUP)
    return rel_bias.astype(jnp.float32)[bucket][:, :, heads].transpose(2, 0, 1)


def _dilated_group(q, k, v, bias, r, k_side):
    B, S, Hg, dh = q.shape
    blk = k_side
    span = r * blk
    P = -(-S // span) * span
    L = P // r
    nb = L // blk
    pad = ((0, 0), (0, P - S), (0, 0), (0, 0))

    def to_blocks(t):
        t = jnp.pad(t, pad).reshape(B, L, r, Hg, dh).transpose(0, 2, 1, 3, 4)
        return t.reshape(B, r, nb, blk, Hg, dh)

    def window(t):
        tp = jnp.pad(t, ((0, 0), (0, 0), (1, 1), (0, 0), (0, 0), (0, 0)))
        return jnp.concatenate([tp[:, :, :-2], tp[:, :, 1:-1], tp[:, :, 2:]], axis=3)

    qb = to_blocks(q)
    kw = window(to_blocks(k))
    vw = window(to_blocks(v)).astype(jnp.float32)

    pos = np.arange(P).reshape(L, r).T.reshape(r, nb, blk)
    posp = np.pad(pos, ((0, 0), (1, 1), (0, 0)), constant_values=-1)
    kpos = np.concatenate([posp[:, :-2], posp[:, 1:-1], posp[:, 2:]], axis=2)
    kvalid = (kpos >= 0) & (kpos < S)
    rel = np.arange(3 * blk)[None, :] - blk - np.arange(blk)[:, None]
    band = np.abs(rel) <= k_side
    mask = band[None, None] & kvalid[:, :, None, :]

    s = jnp.einsum('brnqhd,brnkhd->brnhqk', qb, kw).astype(jnp.float32) * (dh ** -0.5) + bias
    s = jnp.where(mask[:, :, None], s, NEG_INF)
    m = jnp.max(s, axis=-1, keepdims=True)
    e = jnp.exp(s - m)
    den = jnp.sum(e, axis=-1, keepdims=True)
    o = jnp.einsum('brnhqk,brnkhd->brnhqd', e, vw) / den
    lse = (m + jnp.log(den))[..., 0]

    o = o.transpose(0, 1, 2, 4, 3, 5).reshape(B, r, L, Hg, dh).transpose(0, 2, 1, 3, 4)
    o = o.reshape(B, P, Hg, dh)[:, :S]
    lse = lse.transpose(0, 1, 2, 4, 3).reshape(B, r, L, Hg).transpose(0, 2, 1, 3)
    lse = lse.reshape(B, P, Hg)[:, :S]
    return o, lse


def _gla_direction(q, k, v, log_a, strict):
    B, S, H, dk = q.shape
    dv = v.shape[-1]
    C = GLA_CHUNK
    NC = S // C

    def chunks(t):
        return t.reshape(B, NC, C, H, t.shape[-1]).transpose(0, 3, 1, 2, 4)

    q, k, v, log_a = chunks(q), chunks(k), chunks(v), chunks(log_a)
    b = jnp.cumsum(log_a, axis=3)
    q_in = q * jnp.exp(b)
    k_in = k * jnp.exp(-b)
    a = jnp.einsum('bhncd,bhnsd->bhncs', q_in, k_in)
    tri = np.tril(np.ones((C, C), dtype=bool), k=-1 if strict else 0)
    a = jnp.where(tri, a, 0.0)
    o = jnp.einsum('bhncs,bhnsv->bhncv', a, v)

    b_last = b[:, :, :, -1:]
    chunk_kv = jnp.einsum('bhncd,bhncv->nbhdv', k * jnp.exp(b_last - b), v)
    decay = jnp.exp(b_last[:, :, :, 0]).transpose(2, 0, 1, 3)

    def step(state, inp):
        dec, kv = inp
        return dec[..., None] * state + kv, state

    _, s_prev = lax.scan(step, jnp.zeros((B, H, dk, dv), jnp.float32), (decay, chunk_kv))
    o = o + jnp.einsum('bhncd,nbhdv->bhncv', q_in, s_prev)
    return o.transpose(0, 2, 3, 1, 4).reshape(B, S, H, dv)


def setup_inputs(seed: int = 0) -> dict:
    key = jax.random.key(seed)
    ks = jax.random.split(key, 20)
    f32 = jnp.float32
    col_scale = np.ones((IN_COLS,), np.float32)
    off = np.concatenate([[0], np.cumsum(IN_SIZES)])
    col_scale[off[2]:off[3]] = BETA
    col_scale[off[5]:off[6]] = BETA
    nrm = lambda k, shape, scale: jax.random.normal(k, shape, f32) * scale
    return {
        "x": jax.random.normal(ks[0], (BATCH, SEQ, D_MODEL), f32),
        "w_in": nrm(ks[1], (DEPTH, D_MODEL, IN_COLS), D_MODEL ** -0.5) * jnp.asarray(col_scale),
        "rel_bias": nrm(ks[2], (REL_BUCKETS, N_ATTN_HEADS), 0.5),
        "w_lr_fwd": nrm(ks[3], (DEPTH, GLA_RANK, GLA_K_WIDTH), GLA_RANK ** -0.5),
        "b_lr_fwd": nrm(ks[4], (DEPTH, GLA_K_WIDTH), 0.1),
        "w_lr_bwd": nrm(ks[5], (DEPTH, GLA_RANK, GLA_K_WIDTH), GLA_RANK ** -0.5),
        "b_lr_bwd": nrm(ks[6], (DEPTH, GLA_K_WIDTH), 0.1),
        "gla_norm_g": 1.0 + nrm(ks[7], (DEPTH, GLA_V_WIDTH), 0.02),
        "w_attn_branch": nrm(ks[8], (DEPTH, ATTN_OUT_WIDTH, D_MODEL), ATTN_OUT_WIDTH ** -0.5),
        "w_gla_branch": nrm(ks[9], (DEPTH, GLA_V_WIDTH, D_MODEL), GLA_V_WIDTH ** -0.5),
        "w_out": nrm(ks[10], (DEPTH, D_MODEL, D_MODEL), BETA * D_MODEL ** -0.5),
        "ln1_g": 1.0 + nrm(ks[11], (DEPTH, D_MODEL), 0.02),
        "ln1_b": nrm(ks[12], (DEPTH, D_MODEL), 0.02),
        "w_ff1": nrm(ks[13], (DEPTH, D_MODEL, D_FF), BETA * D_MODEL ** -0.5),
        "b_ff1": nrm(ks[14], (DEPTH, D_FF), 0.02),
        "w_ff2": nrm(ks[15], (DEPTH, D_FF, D_MODEL), BETA * D_FF ** -0.5),
        "b_ff2": nrm(ks[16], (DEPTH, D_MODEL), 0.02),
        "ln2_g": 1.0 + nrm(ks[17], (DEPTH, D_MODEL), 0.02),
        "ln2_b": nrm(ks[18], (DEPTH, D_MODEL), 0.02),
    }


def reference(x, w_in, rel_bias, w_lr_fwd, b_lr_fwd, w_lr_bwd, b_lr_bwd, gla_norm_g,
              w_attn_branch, w_gla_branch, w_out, ln1_g, ln1_b, w_ff1, b_ff1, w_ff2, b_ff2,
              ln2_g, ln2_b):
    B, S, _ = x.shape
    f32 = jnp.float32
    for l in range(DEPTH):
        proj = x @ w_in[l]
        (aq, ak, av, gq, gk, gv, gout, lr_f, lr_b, gate_a, gate_g) = jnp.split(proj, IN_SPLITS, axis=-1)

        aq = aq.reshape(B, S, N_ATTN_HEADS, HEAD_DIM)
        ak = ak.reshape(B, S, N_ATTN_HEADS, HEAD_DIM)
        av = av.reshape(B, S, N_ATTN_HEADS, HEAD_DIM)
        outs, lses = [], []
        for gi, (win, dil) in enumerate(ATTN_PAIRS):
            k_side = (win // 2) // dil
            hs = slice(gi * HEADS_PER_GROUP, (gi + 1) * HEADS_PER_GROUP)
            bias = _group_bias(rel_bias, gi, dil, k_side)
            o_g, lse_g = _dilated_group(aq[:, :, hs], ak[:, :, hs], av[:, :, hs], bias, dil, k_side)
            outs.append(o_g)
            lses.append(lse_g)
        mix_w = jax.nn.softmax(jnp.stack(lses, axis=0), axis=0)
        y_attn = jnp.sum(mix_w[..., None] * jnp.stack(outs, axis=0), axis=0)
        y_attn = y_attn.reshape(B, S, ATTN_OUT_WIDTH).astype(x.dtype)

        gq = gq.astype(f32).reshape(B, S, GLA_HEADS, GLA_DK) * (GLA_DK ** -0.5)
        gk = gk.astype(f32).reshape(B, S, GLA_HEADS, GLA_DK)
        gv = gv.astype(f32).reshape(B, S, GLA_HEADS, GLA_DV)
        la_f = (jax.nn.log_sigmoid((lr_f @ w_lr_fwd[l] + b_lr_fwd[l]).astype(f32)) / GLA_TAU
                ).reshape(B, S, GLA_HEADS, GLA_DK)
        la_b = (jax.nn.log_sigmoid((lr_b @ w_lr_bwd[l] + b_lr_bwd[l]).astype(f32)) / GLA_TAU
                ).reshape(B, S, GLA_HEADS, GLA_DK)
        o_fwd = _gla_direction(gq, gk, gv, la_f, False)
        o_bwd = jnp.flip(_gla_direction(jnp.flip(gq, 1), jnp.flip(gk, 1), jnp.flip(gv, 1),
                                        jnp.flip(la_b, 1), True), 1)
        o_gla = o_fwd + o_bwd
        o_gla = o_gla * lax.rsqrt(jnp.mean(jnp.square(o_gla), axis=-1, keepdims=True) + NORM_EPS)
        y_gla = (o_gla.reshape(B, S, GLA_V_WIDTH) * gla_norm_g[l].astype(f32)
                 * jax.nn.silu(gout.astype(f32))).astype(x.dtype)

        merged = (jax.nn.sigmoid(gate_a) * (y_attn @ w_attn_branch[l])
                  + jax.nn.sigmoid(gate_g) * (y_gla @ w_gla_branch[l]))
        x = _layernorm(ALPHA * x + merged @ w_out[l], ln1_g[l], ln1_b[l])

        ff = jnp.square(jax.nn.relu(x @ w_ff1[l] + b_ff1[l])) @ w_ff2[l] + b_ff2[l]
        x = _layernorm(ALPHA * x + ff, ln2_g[l], ln2_b[l])
    return x
```

```cpp
#define MK_PER_PHASE 1
#include <hip/hip_runtime.h>
#include <cstdio>
#include <cstdint>
#include <cmath>
namespace pg8 {
#define PG8_LAS __attribute__((address_space(3)))
typedef unsigned short bf16_t;
typedef short bf16x8 __attribute__((ext_vector_type(8)));
typedef float f32x4 __attribute__((ext_vector_type(4)));
typedef unsigned u32x4 __attribute__((ext_vector_type(4)));
constexpr int BM = 256, BK = 64, HALF = 128, HTB = HALF * BK * 2  , STAGE_BYTES = 8 * HTB, NXCD = 8, WGM = 8;

__host__ __device__ __forceinline__ int lds_byte(int r, int c) { const int st = (r >> 4) * 2 + (c >> 5), rr = r & 15, cc = c & 31, ob = rr * 64 + cc * 2; return st * 1024 + (ob ^ (((ob >> 9) & 1) << 5)); }
__host__ __device__ __forceinline__ void stage_rc(int b, int& R, int& C) { const int st = b / 1024, sb = b % 1024, swz = sb ^ (((sb >> 9) & 1) << 5); R = (st >> 1) * 16 + swz / 64; C = (st & 1) * 32 + (swz % 64) / 2; }
__host__ __device__ __forceinline__ int perm32(int rho) { const int n = rho >> 4, i = rho & 15; return 8 * (i >> 2) + 4 * n + (i & 3); }

struct Unit { int pm, pn; };
struct Gemm { const bf16_t* A; const bf16_t* Bt; int M, N, K; };

struct StaticOrder {
    int nM, nN, nwg, G, c;
    __host__ __device__ void init(int M, int N, int G_, int c_) { nM = M / BM; nN = N / BM; nwg = nM * nN; G = G_; c = c_; }
    __host__ __device__ bool next(int i, Unit& u) const {
        const long L = (long)i * G + c; if (L >= nwg) return false;
        int wgid = (int)L; { const int q = nwg / NXCD, r = nwg % NXCD, xcd = wgid % NXCD, off = wgid / NXCD; wgid = (xcd < r ? xcd * (q + 1) : r * (q + 1) + (xcd - r) * q) + off; }
        const int nig = WGM * nN, gid = wgid / nig, fm = gid * WGM, gsz = (nM - fm) < WGM ? (nM - fm) : WGM;
        u.pm = fm + ((wgid % nig) % gsz); u.pn = (wgid % nig) / gsz; return true;
    }
    __device__ __forceinline__ void a_ready(const Unit&) const {}
    __device__ __forceinline__ void done(const Unit&) const {}
};

__device__ __forceinline__ unsigned cvt_pk_bf16(float lo, float hi) { unsigned r; asm volatile("v_cvt_pk_bf16_f32 %0, %1, %2" : "=v"(r) : "v"(lo), "v"(hi)); return r; }
typedef float f32x2 __attribute__((ext_vector_type(2)));
__device__ __forceinline__ float bf2f(unsigned short h) { return __builtin_bit_cast(float, (unsigned)h << 16); }
__device__ __forceinline__ float sigmoidf_fast(float v) { return __builtin_amdgcn_rcpf(1.0f + __expf(-v)); }
struct EpiProj {
    static constexpr bool PERM = true, AFTER_DRAIN = false;
    bf16_t *QKV, *GQK, *GV, *GOUT, *GATES; float* LR;
    __device__ __forceinline__ void operator()(const f32x4 (&acc)[2][2][4][2], const Unit& u, int wr, int wc, int fr, int fq) const {
        const int pn = u.pn, row0 = u.pm * BM + wr * 64 + fr, c0 = wc * 32 + 8 * fq;
        if (pn == 15) {
            if (wc == 0) {
#pragma unroll
                for (int ai = 0; ai < 2; ++ai)
#pragma unroll
                    for (int m = 0; m < 4; ++m) { float* p = LR + (size_t)(row0 + ai * HALF + m * 16) * 32 + 8 * fq; *(f32x4*)p = acc[ai][0][m][0]; *(f32x4*)(p + 4) = acc[ai][0][m][1]; }
            }
            return;
        }
        bf16_t* base; int ldc, colt, op;
        if (pn < 9) { base = QKV; ldc = 2304; colt = pn * 256; op = pn < 3 ? 1 : 0; }
        else if (pn < 11) { base = GQK; ldc = 512; colt = (pn - 9) * 256; op = pn == 9 ? 1 : 0; }
        else if (pn < 13) { base = GV; ldc = 512; colt = (pn - 11) * 256; op = 0; }
        else if (pn < 15) { base = GOUT; ldc = 512; colt = (pn - 13) * 256; op = 2; }
        else { base = GATES; ldc = 2048; colt = (pn - 16) * 256; op = 3; }
#pragma unroll
        for (int ai = 0; ai < 2; ++ai)
#pragma unroll
            for (int m = 0; m < 4; ++m) { bf16_t* rowp = base + (size_t)(row0 + ai * HALF + m * 16) * ldc + colt + c0;
#pragma unroll
                for (int bj = 0; bj < 2; ++bj) { f32x4 v0 = acc[ai][bj][m][0], v1 = acc[ai][bj][m][1];
                    if (op == 1) { v0 = v0 * 0.125f; v1 = v1 * 0.125f; }
                    else if (op == 2) {
#pragma unroll
                        for (int e = 0; e < 4; ++e) { v0[e] = v0[e] * sigmoidf_fast(v0[e]); v1[e] = v1[e] * sigmoidf_fast(v1[e]); } }
                    else if (op == 3) {
#pragma unroll
                        for (int e = 0; e < 4; ++e) { v0[e] = sigmoidf_fast(v0[e]); v1[e] = sigmoidf_fast(v1[e]); } }
                    u32x4 w; w.x = cvt_pk_bf16(v0[0], v0[1]); w.y = cvt_pk_bf16(v0[2], v0[3]); w.z = cvt_pk_bf16(v1[0], v1[1]); w.w = cvt_pk_bf16(v1[2], v1[3]);
                    *(u32x4*)(rowp + bj * HALF) = w; } }
    }
};
struct EpiSqRelu {
    static constexpr bool PERM = true, AFTER_DRAIN = false;
    bf16_t* O; int ldc; const float* bias;
    __device__ __forceinline__ void operator()(const f32x4 (&acc)[2][2][4][2], const Unit& u, int wr, int wc, int fr, int fq) const {
        const int row0 = u.pm * BM + wr * 64 + fr, col0 = u.pn * BM + wc * 32 + 8 * fq;
        f32x4 bv[2][2];
#pragma unroll
        for (int bj = 0; bj < 2; ++bj)
#pragma unroll
            for (int n = 0; n < 2; ++n) bv[bj][n] = *(const f32x4*)(bias + col0 + bj * HALF + 4 * n);
#pragma unroll
        for (int ai = 0; ai < 2; ++ai)
#pragma unroll
            for (int m = 0; m < 4; ++m) { bf16_t* rowp = O + (size_t)(row0 + ai * HALF + m * 16) * ldc + col0;
#pragma unroll
                for (int bj = 0; bj < 2; ++bj) { f32x4 v0 = acc[ai][bj][m][0] + bv[bj][0], v1 = acc[ai][bj][m][1] + bv[bj][1];
#pragma unroll
                    for (int e = 0; e < 4; ++e) { const float a = fmaxf(v0[e], 0.f), b = fmaxf(v1[e], 0.f); v0[e] = a * a; v1[e] = b * b; }
                    u32x4 w; w.x = cvt_pk_bf16(v0[0], v0[1]); w.y = cvt_pk_bf16(v0[2], v0[3]); w.z = cvt_pk_bf16(v1[0], v1[1]); w.w = cvt_pk_bf16(v1[2], v1[3]);
                    *(u32x4*)(rowp + bj * HALF) = w; } }
    }
};
template <bool SECOND> struct EpiMerge {
    static constexpr bool PERM = true, AFTER_DRAIN = false;
    const bf16_t* gates; int goff; float* part; bf16_t* merged;
    __device__ __forceinline__ void operator()(const f32x4 (&acc)[2][2][4][2], const Unit& u, int wr, int wc, int fr, int fq) const {
        const int row0 = u.pm * BM + wr * 64 + fr, col0 = u.pn * BM + wc * 32 + 8 * fq;
#pragma unroll
        for (int ai = 0; ai < 2; ++ai)
#pragma unroll
            for (int m = 0; m < 4; ++m) { const size_t row = (size_t)(row0 + ai * HALF + m * 16);
#pragma unroll
                for (int bj = 0; bj < 2; ++bj) { const int col = col0 + bj * HALF;
                    const u32x4 gw = *(const u32x4*)(gates + row * 2048 + goff + col);
                    f32x4 g0, g1; g0[0] = __builtin_bit_cast(float, gw.x << 16); g0[1] = __builtin_bit_cast(float, gw.x & 0xffff0000u); g0[2] = __builtin_bit_cast(float, gw.y << 16); g0[3] = __builtin_bit_cast(float, gw.y & 0xffff0000u);
                    g1[0] = __builtin_bit_cast(float, gw.z << 16); g1[1] = __builtin_bit_cast(float, gw.z & 0xffff0000u); g1[2] = __builtin_bit_cast(float, gw.w << 16); g1[3] = __builtin_bit_cast(float, gw.w & 0xffff0000u);
                    f32x4 v0 = acc[ai][bj][m][0] * g0, v1 = acc[ai][bj][m][1] * g1; float* pp = part + row * 1024 + col;
                    if (!SECOND) { *(f32x4*)pp = v0; *(f32x4*)(pp + 4) = v1; }
                    else { v0 = v0 + *(const f32x4*)pp; v1 = v1 + *(const f32x4*)(pp + 4);
                        u32x4 w; w.x = cvt_pk_bf16(v0[0], v0[1]); w.y = cvt_pk_bf16(v0[2], v0[3]); w.z = cvt_pk_bf16(v1[0], v1[1]); w.w = cvt_pk_bf16(v1[2], v1[3]);
                        *(u32x4*)(merged + row * 1024 + col) = w; } }
                asm volatile("" ::: "memory"); }
    }
};
struct EpiResF32 {
    static constexpr bool PERM = true, AFTER_DRAIN = false;
    const float* base; float* out; const float* bias; float alpha;
    __device__ __forceinline__ void operator()(const f32x4 (&acc)[2][2][4][2], const Unit& u, int wr, int wc, int fr, int fq) const {
        const int row0 = u.pm * BM + wr * 64 + fr, col0 = u.pn * BM + wc * 32 + 8 * fq;
        f32x4 bv[2][2];
#pragma unroll
        for (int bj = 0; bj < 2; ++bj)
#pragma unroll
            for (int n = 0; n < 2; ++n) bv[bj][n] = bias ? *(const f32x4*)(bias + col0 + bj * HALF + 4 * n) : (f32x4){0.f, 0.f, 0.f, 0.f};
#pragma unroll
        for (int ai = 0; ai < 2; ++ai)
#pragma unroll
            for (int m = 0; m < 4; ++m) { const size_t off = (size_t)(row0 + ai * HALF + m * 16) * 1024 + col0;
#pragma unroll
                for (int bj = 0; bj < 2; ++bj) { const f32x4 b0 = *(const f32x4*)(base + off + bj * HALF), b1 = *(const f32x4*)(base + off + bj * HALF + 4);
                    *(f32x4*)(out + off + bj * HALF) = b0 * alpha + acc[ai][bj][m][0] + bv[bj][0]; *(f32x4*)(out + off + bj * HALF + 4) = b1 * alpha + acc[ai][bj][m][1] + bv[bj][1]; }
                asm volatile("" ::: "memory"); }
    }
};
template <class Epi, class Sched, bool ALIGN_EPI = false, bool SP2 = false>
__device__ __forceinline__ void gemm_phase(PG8_LAS unsigned char* lds, const Gemm g, const Sched& S, const Epi& E) {
    int tid_ = threadIdx.x; asm volatile("" : "+v"(tid_));
    const int tid = tid_, wid = __builtin_amdgcn_readfirstlane(tid >> 6), lane = tid & 63, wr = wid >> 2, wc = wid & 3, fr = lane & 15, fq = lane >> 4;
    const int K = g.K, nt = K / BK;
    unsigned voffA[2], voffB[2];
#pragma unroll
    for (int i = 0; i < 2; ++i) { int R, C; stage_rc(tid * 16 + i * 8192, R, C); const int Rb = Epi::PERM ? ((R & ~31) + perm32(R & 31)) : R;
        voffA[i] = (unsigned)(R * K + C) * 2u; voffB[i] = (unsigned)(Rb * K + C) * 2u; }
    const size_t kstep = (size_t)(BK * 2);
    const size_t hstep = (size_t)HALF * K * 2;
    const size_t tstep = 2 * hstep;
    const unsigned ldsw = (unsigned)wid * 1024u;
    const int aoff = lds_byte(wr * 64 + fr, fq * 8), boff = lds_byte(wc * 32 + fr, fq * 8);
#define PG8_SA(b, h) (((b) * 2 + (h)) * HTB)
#define PG8_SB(b, h) ((4 + (b) * 2 + (h)) * HTB)
#define PG8_STAGE(bufoff, gbase, voff) do { _Pragma("unroll") for (int _i = 0; _i < 2; ++_i) \
        __builtin_amdgcn_global_load_lds((const unsigned*)((const char*)(gbase) + (voff)[_i]), (PG8_LAS unsigned*)(lds + (bufoff) + ldsw + _i * 8192), 16, 0, 0); } while (0)
#define PG8_LDA(dst, b, h) do { _Pragma("unroll") for (int m = 0; m < 4; ++m) _Pragma("unroll") for (int k = 0; k < 2; ++k) dst[m][k] = *(const PG8_LAS bf16x8*)(lds + PG8_SA(b, h) + aoff + m * 2048 + k * 1024); } while (0)
#define PG8_LDB(dst, b, h) do { _Pragma("unroll") for (int n = 0; n < 2; ++n) _Pragma("unroll") for (int k = 0; k < 2; ++k) dst[n][k] = *(const PG8_LAS bf16x8*)(lds + PG8_SB(b, h) + boff + n * 2048 + k * 1024); } while (0)
#define PG8_MMA(ai, bj, At, Bt) do { __builtin_amdgcn_s_setprio(1); _Pragma("unroll") for (int m = 0; m < 4; ++m) _Pragma("unroll") for (int n = 0; n < 2; ++n) _Pragma("unroll") for (int k = 0; k < 2; ++k) \
        acc[ai][bj][m][n] = __builtin_amdgcn_mfma_f32_16x16x32_bf16(Bt[n][k], At[m][k], acc[ai][bj][m][n], 0, 0, 0); __builtin_amdgcn_s_setprio(0); } while (0)
#define PG8_WAIT_V(n) asm volatile("s_waitcnt vmcnt(" #n ")" ::: "memory")
#define PG8_WAIT_L(n) asm volatile("s_waitcnt lgkmcnt(" #n ")" ::: "memory")
#define PG8_BAR __builtin_amdgcn_s_barrier()
#define PG8_SCHED __builtin_amdgcn_sched_barrier(0)
    Unit cur, nxt; int ui = 0;
    if (!S.next(0, cur)) return;
    f32x4 acc[2][2][4][2];
#pragma unroll
    for (int a = 0; a < 2; ++a)
#pragma unroll
        for (int b = 0; b < 2; ++b)
#pragma unroll
            for (int m = 0; m < 4; ++m)
#pragma unroll
                for (int n = 0; n < 2; ++n) acc[a][b][m][n] = (f32x4){0.f, 0.f, 0.f, 0.f};
    bf16x8 At[4][2], B0[2][2], B1[2][2];
    const char* cA = (const char*)g.A + (size_t)cur.pm * tstep; const char* cB = (const char*)g.Bt + (size_t)cur.pn * tstep;
    S.a_ready(cur);
    if constexpr (SP2) {
        PG8_STAGE(PG8_SB(0, 0), cB, voffB); PG8_STAGE(PG8_SB(0, 1), cB + hstep, voffB); PG8_STAGE(PG8_SA(0, 0), cA, voffA); PG8_STAGE(PG8_SA(0, 1), cA + hstep, voffA);
        if (wr == 1) PG8_BAR;
        PG8_WAIT_V(2); PG8_BAR;
        PG8_STAGE(PG8_SB(1, 0), cB + kstep, voffB); PG8_STAGE(PG8_SA(1, 0), cA + kstep, voffA); PG8_STAGE(PG8_SB(1, 1), cB + hstep + kstep, voffB);
        PG8_WAIT_V(6); PG8_BAR;
    } else {
        PG8_STAGE(PG8_SB(0, 0), cB, voffB); PG8_STAGE(PG8_SA(0, 0), cA, voffA); PG8_STAGE(PG8_SB(0, 1), cB + hstep, voffB); PG8_STAGE(PG8_SA(0, 1), cA + hstep, voffA);
        if (wr == 1) PG8_BAR;
        PG8_WAIT_V(4); PG8_BAR;
        PG8_STAGE(PG8_SB(1, 0), cB + kstep, voffB); PG8_STAGE(PG8_SA(1, 0), cA + kstep, voffA); PG8_STAGE(PG8_SB(1, 1), cB + hstep + kstep, voffB);
        PG8_WAIT_V(6); PG8_BAR;
    }
    for (;;) {
        const bool has_next = S.next(ui + 1, nxt);
        const char* nA = has_next ? (const char*)g.A + (size_t)nxt.pm * tstep : cA; const char* nB = has_next ? (const char*)g.Bt + (size_t)nxt.pn * tstep : cB;
        for (int t = 0; t < nt; t += 2) {
            const bool last = (t == nt - 2);
            const char* a1 = cA + (size_t)(t + 1) * kstep;
            const char* a2 = last ? nA : cA + (size_t)(t + 2) * kstep; const char* b2 = last ? nB : cB + (size_t)(t + 2) * kstep;
            const char* a3 = a2 + kstep; const char* b3 = b2 + kstep;
            if (last && has_next) S.a_ready(nxt);
            if constexpr (SP2) {
            PG8_LDB(B0, 0, 0); PG8_LDB(B1, 0, 1); PG8_SCHED; PG8_LDA(At, 0, 0); PG8_STAGE(PG8_SA(1, 1), a1 + hstep, voffA);
            PG8_WAIT_V(8); PG8_WAIT_L(0); PG8_BAR; PG8_MMA(0, 0, At, B0); PG8_MMA(0, 1, At, B1); PG8_BAR; PG8_SCHED;
            PG8_LDA(At, 0, 1); PG8_STAGE(PG8_SB(0, 0), b2, voffB); PG8_STAGE(PG8_SB(0, 1), b2 + hstep, voffB); PG8_STAGE(PG8_SA(0, 0), a2, voffA);
            PG8_WAIT_V(8); PG8_WAIT_L(0); PG8_BAR; PG8_MMA(1, 0, At, B0); PG8_MMA(1, 1, At, B1); PG8_BAR; PG8_SCHED;
            PG8_LDB(B0, 1, 0); PG8_LDB(B1, 1, 1); PG8_SCHED; PG8_LDA(At, 1, 0); PG8_STAGE(PG8_SA(0, 1), a2 + hstep, voffA);
            PG8_WAIT_V(8); PG8_WAIT_L(0); PG8_BAR; PG8_MMA(0, 0, At, B0); PG8_MMA(0, 1, At, B1); PG8_BAR; PG8_SCHED;
            PG8_LDA(At, 1, 1); PG8_STAGE(PG8_SB(1, 0), b3, voffB); PG8_STAGE(PG8_SB(1, 1), b3 + hstep, voffB); PG8_STAGE(PG8_SA(1, 0), a3, voffA);
            PG8_WAIT_V(8); PG8_WAIT_L(0); PG8_BAR; PG8_MMA(1, 0, At, B0); PG8_MMA(1, 1, At, B1); PG8_BAR; PG8_SCHED;
            } else {
            PG8_LDB(B0, 0, 0); PG8_SCHED; PG8_LDA(At, 0, 0); PG8_STAGE(PG8_SA(1, 1), a1 + hstep, voffA);
            PG8_WAIT_L(8); PG8_BAR; PG8_WAIT_L(0); PG8_MMA(0, 0, At, B0); PG8_BAR; PG8_SCHED;
            PG8_LDB(B1, 0, 1); PG8_STAGE(PG8_SB(0, 0), b2, voffB);
            PG8_BAR; PG8_WAIT_L(0); PG8_MMA(0, 1, At, B1); PG8_BAR;
            PG8_LDA(At, 0, 1); PG8_STAGE(PG8_SA(0, 0), a2, voffA);
            PG8_BAR; PG8_WAIT_L(0); PG8_MMA(1, 0, At, B0); PG8_BAR; PG8_SCHED;
            PG8_STAGE(PG8_SB(0, 1), b2 + hstep, voffB);
            PG8_WAIT_V(6); PG8_BAR; PG8_MMA(1, 1, At, B1); PG8_BAR;
            PG8_LDB(B0, 1, 0); PG8_SCHED; PG8_LDA(At, 1, 0); PG8_STAGE(PG8_SA(0, 1), a2 + hstep, voffA);
            PG8_WAIT_L(8); PG8_BAR; PG8_WAIT_L(0); PG8_MMA(0, 0, At, B0); PG8_BAR; PG8_SCHED;
            PG8_LDB(B1, 1, 1); PG8_STAGE(PG8_SB(1, 0), b3, voffB);
            PG8_BAR; PG8_WAIT_L(0); PG8_MMA(0, 1, At, B1); PG8_BAR;
            PG8_LDA(At, 1, 1); PG8_STAGE(PG8_SA(1, 0), a3, voffA);
            PG8_BAR; PG8_WAIT_L(0); PG8_MMA(1, 0, At, B0); PG8_BAR; PG8_SCHED;
            PG8_STAGE(PG8_SB(1, 1), b3 + hstep, voffB);
            PG8_WAIT_V(6); PG8_BAR; PG8_MMA(1, 1, At, B1); PG8_BAR;
            }
        }
        if constexpr (ALIGN_EPI) { if (wr == 0) PG8_BAR; }
        if constexpr (!Epi::AFTER_DRAIN) { E(acc, cur, wr, wc, fr, fq); S.done(cur); }
        if (!has_next) break;
#pragma unroll
        for (int a = 0; a < 2; ++a)
#pragma unroll
            for (int b = 0; b < 2; ++b)
#pragma unroll
                for (int m = 0; m < 4; ++m)
#pragma unroll
                    for (int n = 0; n < 2; ++n) acc[a][b][m][n] = (f32x4){0.f, 0.f, 0.f, 0.f};
        cur = nxt; cA = nA; cB = nB; ++ui;
        if constexpr (ALIGN_EPI) { if (wr == 1) PG8_BAR; }
    }
    PG8_WAIT_V(0);
    if constexpr (!ALIGN_EPI) { if (wr == 0) PG8_BAR; }
    PG8_BAR;
    if constexpr (Epi::AFTER_DRAIN) { E.fused(acc, cur, wr, wc, fr, fq, lds, wid, lane); S.done(cur); }
#undef PG8_SA
#undef PG8_SB
#undef PG8_STAGE
#undef PG8_LDA
#undef PG8_LDB
#undef PG8_MMA
#undef PG8_WAIT_V
#undef PG8_WAIT_L
#undef PG8_BAR
#undef PG8_SCHED
}
}
#define PG8_SP2 true
#define PG8_ALIGN true
#define GAS __attribute__((address_space(1)))
#define LAS __attribute__((address_space(3)))
typedef unsigned short bf16;
typedef unsigned v4u __attribute__((ext_vector_type(4)));
typedef float f32x4 __attribute__((ext_vector_type(4)));
typedef short bf16x8 __attribute__((ext_vector_type(8)));
typedef GAS unsigned gu32;
typedef GAS unsigned long long gu64;
#define RLX_AGENT __ATOMIC_RELAXED, __HIP_MEMORY_SCOPE_AGENT
#define LDS_WAIT() asm volatile("s_waitcnt lgkmcnt(0)" ::: "memory")
#define VM_WAIT() asm volatile("s_waitcnt vmcnt(0)" ::: "memory")
__device__ __forceinline__ unsigned long long rt() { return __builtin_amdgcn_s_memrealtime(); }
__device__ __forceinline__ unsigned f2bf(float f) { unsigned u = __builtin_bit_cast(unsigned, f); return (u + 0x7fffu + ((u >> 16) & 1u)) >> 16; }
__device__ __forceinline__ unsigned pk2(float lo, float hi) { return f2bf(lo) | (f2bf(hi) << 16); }

#define XB_TMO      128
#define XB_XCNT(j)  (256  + 64 * (j))
#define XB_XSUB(j)  (1280 + 64 * (j))
#define XB_XGEN(j)  (2304 + 64 * (j))
#define XB_TOP      3328
#define XB_TOPGEN   3392
#define XCD_BAR_WORDS 3456
#define XB_SPIN_CAP (1u << 18)

__device__ __forceinline__ unsigned xb_ld(unsigned* p)              { return __hip_atomic_load(p, __ATOMIC_RELAXED, __HIP_MEMORY_SCOPE_AGENT); }
__device__ __forceinline__ unsigned xb_add(unsigned* p, unsigned v) { return __hip_atomic_fetch_add(p, v, __ATOMIC_RELAXED, __HIP_MEMORY_SCOPE_AGENT); }
__device__ __forceinline__ unsigned xb_xcc_id() { return (unsigned)__builtin_amdgcn_s_getreg((3 << 11) | 20) & 0xFu; }
#define XB_SPIN(cond, bar) do { unsigned _sp = 0; while (cond) { __builtin_amdgcn_s_sleep(1); \
    if ((++_sp & 255u) == 0u) { if (xb_ld(&(bar)[XB_TMO])) break; if (_sp > XB_SPIN_CAP) { atomicAdd(&(bar)[XB_TMO], 1u); break; } } } } while (0)

struct XcdBarrier {
    unsigned* bar; unsigned x;
    volatile LAS unsigned* st;
};

__device__ __forceinline__ XcdBarrier xcd_barrier_post(unsigned* bar, volatile LAS unsigned* st) {
    XcdBarrier b; b.bar = bar; b.x = xb_xcc_id(); b.st = st;
    if (threadIdx.x == 0) (void)xb_add(&bar[XB_XCNT(b.x)], 1u);
    return b;
}
__device__ __forceinline__ void xcd_barrier_complete(unsigned* bar, unsigned x, unsigned& nloc, unsigned& nx) {
    const unsigned G = gridDim.x * gridDim.y * gridDim.z;
    unsigned sum, cnt, mine, sp = 0u;
    for (;;) {
        sum = 0u; cnt = 0u; mine = 0u;
#pragma unroll
        for (unsigned j = 0; j < 16; ++j) { const unsigned c = xb_ld(&bar[XB_XCNT(j)]); sum += c; cnt += (c > 0u) ? 1u : 0u; mine = (j == x) ? c : mine; }
        if (sum == G) break;
        __builtin_amdgcn_s_sleep(1);
        if ((++sp & 255u) == 0u) { if (xb_ld(&bar[XB_TMO])) break; if (sp > XB_SPIN_CAP) { atomicAdd(&bar[XB_TMO], 1u); break; } }
    }
    nloc = mine > 0u ? mine : 1u; nx = cnt > 0u ? cnt : 1u;
}

__device__ __forceinline__ void xcd_barrier(const XcdBarrier& b) {
    asm volatile("s_waitcnt vmcnt(0)" ::: "memory");
    __syncthreads();
    if (threadIdx.x == 0) {
        unsigned* bar = b.bar;
        __builtin_amdgcn_s_waitcnt(0);
        unsigned nloc = b.st[0], nx = b.st[1];
        if (nloc == 0u) { xcd_barrier_complete(bar, b.x, nloc, nx); b.st[0] = nloc; b.st[1] = nx; }
        const unsigned old = xb_add(&bar[XB_XSUB(b.x)], 1u);
        const unsigned gen = old / nloc;
        if (old + 1u == (gen + 1u) * nloc) {
            __builtin_amdgcn_fence(__ATOMIC_RELEASE, "agent");
            asm volatile("s_waitcnt vmcnt(0)" ::: "memory");
            const unsigned og = xb_add(&bar[XB_TOP], 1u);
            const unsigned tg = og / nx;
            if (og + 1u == (tg + 1u) * nx) xb_add(&bar[XB_TOPGEN], 1u);
            else XB_SPIN(xb_ld(&bar[XB_TOPGEN]) == tg, bar);
            __builtin_amdgcn_fence(__ATOMIC_ACQUIRE, "agent");
            xb_add(&bar[XB_XGEN(b.x)], 1u);
            asm volatile("s_waitcnt vmcnt(0)" ::: "memory");
        } else {
            XB_SPIN(xb_ld(&bar[XB_XGEN(b.x)]) == gen, bar);
            __builtin_amdgcn_fence(__ATOMIC_ACQUIRE, "agent");
            asm volatile("s_waitcnt vmcnt(0)" ::: "memory");
        }
    }
    __syncthreads();
}

constexpr int NWAVES = 8;
constexpr int BATCH = 8, SEQ = 2048, D = 1024, M = BATCH * SEQ, FF = 4096;
constexpr int IN_COLS = 5920, NPROJ = 6144, QKVW = 2304;
constexpr float ALPHA = 1.18920711500272106672f;
constexpr float LN_EPS = 1e-5f, NORM_EPS = 1e-6f;
constexpr int NPH = 11;
#ifndef MK_PER_PHASE
#define MK_PER_PHASE 0
#endif

constexpr size_t MiB = 1u << 20;
constexpr size_t WS_CTL = 0, CTL_ZERO_BYTES = 1 * MiB;
constexpr size_t WS_WOUT = 1 * MiB, WS_WAB = 3 * MiB, WS_WGB = 4 * MiB, WS_WFF1 = 5 * MiB, WS_WFF2 = 13 * MiB, WS_WIN = 21 * MiB;
constexpr size_t WS_YATTN = 21 * MiB, WS_DEC = 29 * MiB;
constexpr size_t WS_XB = 33 * MiB;
constexpr size_t WS_STATES = 33 * MiB;
constexpr size_t WS_X1B = 33 * MiB;
constexpr size_t WS_QKV = 65 * MiB;
constexpr size_t WS_GQK = 137 * MiB, WS_GV = 153 * MiB, WS_GOUT = 169 * MiB;
constexpr size_t WS_LR = 185 * MiB;
constexpr size_t WS_GATES = 187 * MiB;
constexpr size_t WS_PART = 65 * MiB;
constexpr size_t WS_MERGED = 129 * MiB;
constexpr size_t WS_H = 65 * MiB;
constexpr size_t WS_END = 251 * MiB;
constexpr int CW_TMO = 0, CW_CODE = 1, CW_BAR = 4096;

constexpr int RING_OFF = 0, RING_BYTES = 131072;
constexpr int LDSCTL_OFF = RING_BYTES, MISC_OFF = LDSCTL_OFF + 320;
constexpr int LDS_BYTES = 147456;

__device__ const unsigned char T5B[3][132] = {
 {11,11,11,11,11,11,11,11,11,11,11,11,11,11,11,10,10,10,10,10,10,10,10,10,10,10,10,10,10,10,10,10,10,10,10,10,10,10,9,9,9,9,9,9,9,9,9,9,9,9,8,8,8,8,8,8,8,7,6,5,4,3,2,1,0,17,18,19,20,21,22,23,24,24,24,24,24,24,24,25,25,25,25,25,25,25,25,25,25,25,25,26,26,26,26,26,26,26,26,26,26,26,26,26,26,26,26,26,26,26,26,26,26,26,27,27,27,27,27,27,27,27,27,27,27,27,27,27,27,0,0,0},
 {13,13,13,13,13,13,13,13,13,13,13,13,13,13,13,13,13,13,13,13,13,13,13,12,12,12,12,12,12,12,12,12,12,12,12,12,12,12,12,12,12,12,11,11,11,11,11,11,11,11,11,11,10,10,10,10,10,10,9,9,9,8,8,4,0,20,24,24,25,25,25,26,26,26,26,26,26,27,27,27,27,27,27,27,27,27,27,28,28,28,28,28,28,28,28,28,28,28,28,28,28,28,28,28,28,28,29,29,29,29,29,29,29,29,29,29,29,29,29,29,29,29,29,29,29,29,29,29,29,0,0,0},
 {15,15,15,15,15,15,15,15,15,15,15,15,15,15,15,15,15,15,15,15,15,15,15,15,15,15,15,15,15,15,14,14,14,14,14,14,14,14,14,14,14,14,14,14,14,13,13,13,13,13,13,13,13,13,12,12,12,12,12,11,11,10,10,9,0,25,26,26,27,27,28,28,28,28,28,29,29,29,29,29,29,29,29,29,30,30,30,30,30,30,30,30,30,30,30,30,30,30,30,31,31,31,31,31,31,31,31,31,31,31,31,31,31,31,31,31,31,31,31,31,31,31,31,31,31,31,31,31,31,0,0,0}};

struct Frame {
    LAS unsigned char* lds;
    volatile LAS unsigned* MISC;
    gu32* ctl;
    int tid, lane, wave;
    int vcu, G;
    const float* x; float* out;
    const float *w_in, *rel_bias, *w_lr_f, *b_lr_f, *w_lr_b, *b_lr_b, *gla_g, *w_ab, *w_gb, *w_out, *ln1_g, *ln1_b, *w_ff1, *b_ff1, *w_ff2, *b_ff2, *ln2_g, *ln2_b;
    bf16 *WIN_t, *WAB_t, *WGB_t, *WOUT_t, *WFF1_t, *WFF2_t;
    bf16 *XB, *QKV, *GQK, *GV, *GOUT, *GATES, *YATTN, *STATES, *MERGED, *X1B, *HB;
    float *LR, *DEC, *PART;
};
__device__ __forceinline__ float bf2f(bf16 h) { return __builtin_bit_cast(float, (unsigned)h << 16); }
__device__ __forceinline__ float wave_sum(float v) {
#pragma unroll
    for (int o = 1; o < 64; o <<= 1) v += __shfl_xor(v, o);
    return v;
}
__device__ __forceinline__ float wave_max(float v) {
#pragma unroll
    for (int o = 1; o < 64; o <<= 1) v = fmaxf(v, __shfl_xor(v, o));
    return v;
}
__device__ __forceinline__ float rdlane(float v, int l) { return __builtin_bit_cast(float, __builtin_amdgcn_readlane(__builtin_bit_cast(int, v), l)); }

template <bool REMAP>
__device__ __forceinline__ void p0_transpose_item(const float* W, int K, int N, bf16* WT, LAS float* scr, int item, int lane) {
    const int nblk = N / 32, kb = item / nblk, nb = item % nblk, k0 = 64 * kb, n0 = 32 * nb;
    const int row_off = (REMAP && n0 >= 3872) ? 224 : 0;
#pragma unroll 8
    for (int i = 0; i < 32; ++i) { const int kk = 2 * i + (lane >> 5); scr[kk * 33 + (lane & 31)] = W[(size_t)(k0 + kk) * N + n0 + (lane & 31)]; }
    LDS_WAIT(); asm volatile("" ::: "memory");
    const int c = lane & 7;
#pragma unroll
    for (int j = 0; j < 4; ++j) { const int n = (lane >> 3) + 8 * j; const LAS float* s = scr + (8 * c) * 33 + n;
        v4u o; o.x = pk2(s[0 * 33], s[1 * 33]); o.y = pk2(s[2 * 33], s[3 * 33]); o.z = pk2(s[4 * 33], s[5 * 33]); o.w = pk2(s[6 * 33], s[7 * 33]);
        *(GAS v4u*)(WT + (size_t)(row_off + n0 + n) * K + k0 + 8 * c) = o; }
    LDS_WAIT(); asm volatile("" ::: "memory");
}
__device__ __forceinline__ void p0_prologue(Frame& F) {
    LAS float* scr = (LAS float*)(F.lds + RING_OFF + F.wave * 16384);
    const int gw = F.vcu * NWAVES + F.wave, NGW = F.G * NWAVES;
    constexpr int I_IN = (D / 64) * (IN_COLS / 32), I_AB = (256 / 64) * (D / 32), I_GB = (512 / 64) * (D / 32), I_OUT = (D / 64) * (D / 32), I_1 = (D / 64) * (FF / 32), I_2 = (FF / 64) * (D / 32);
    constexpr int NITEMS = I_IN + I_AB + I_GB + I_OUT + I_1 + I_2;
    for (int it = gw; it < NITEMS; it += NGW) {
        int r = it;
        if (r < I_IN) { p0_transpose_item<true>(F.w_in, D, IN_COLS, F.WIN_t, scr, r, F.lane); continue; } r -= I_IN;
        if (r < I_AB) { p0_transpose_item<false>(F.w_ab, 256, D, F.WAB_t, scr, r, F.lane); continue; } r -= I_AB;
        if (r < I_GB) { p0_transpose_item<false>(F.w_gb, 512, D, F.WGB_t, scr, r, F.lane); continue; } r -= I_GB;
        if (r < I_OUT) { p0_transpose_item<false>(F.w_out, D, D, F.WOUT_t, scr, r, F.lane); continue; } r -= I_OUT;
        if (r < I_1) { p0_transpose_item<false>(F.w_ff1, D, FF, F.WFF1_t, scr, r, F.lane); continue; } r -= I_1;
        p0_transpose_item<false>(F.w_ff2, FF, D, F.WFF2_t, scr, r, F.lane);
    }
    for (int rr = gw; rr < 224; rr += NGW) { GAS v4u* o = (GAS v4u*)(F.WIN_t + (size_t)(3872 + rr) * D) + F.lane; o[0] = (v4u){0u, 0u, 0u, 0u}; o[64] = (v4u){0u, 0u, 0u, 0u}; }
    for (int m = gw; m < M; m += NGW) {
        const GAS f32x4* xr = (const GAS f32x4*)(F.x + (size_t)m * D) + F.lane;
        GAS unsigned long long* o8 = (GAS unsigned long long*)(F.XB + (size_t)m * D) + F.lane;
#pragma unroll
        for (int j = 0; j < 4; ++j) { const f32x4 v = xr[64 * j]; o8[64 * j] = (unsigned long long)pk2(v.x, v.y) | ((unsigned long long)pk2(v.z, v.w) << 32); }
    }
}

__device__ __forceinline__ void ln_rows(Frame& F, float* buf, const float* g, const float* b, bf16* ob) {
    const int gw = F.vcu * NWAVES + F.wave, NGW = F.G * NWAVES;
    for (int m = gw; m < M; m += NGW) {
        GAS f32x4* xr = (GAS f32x4*)(buf + (size_t)m * D) + F.lane;
        f32x4 v[4]; float s = 0.f;
#pragma unroll
        for (int j = 0; j < 4; ++j) { v[j] = xr[64 * j]; s += (v[j].x + v[j].y) + (v[j].z + v[j].w); }
        const float mean = wave_sum(s) * (1.f / D); float s2 = 0.f;
#pragma unroll
        for (int j = 0; j < 4; ++j) { v[j] = v[j] - mean; s2 += (v[j].x * v[j].x + v[j].y * v[j].y) + (v[j].z * v[j].z + v[j].w * v[j].w); }
        const float rstd = 1.f / sqrtf(wave_sum(s2) * (1.f / D) + LN_EPS);
#pragma unroll
        for (int j = 0; j < 4; ++j) { const f32x4 gg = *((const GAS f32x4*)g + F.lane + 64 * j), bb = *((const GAS f32x4*)b + F.lane + 64 * j);
            const f32x4 o = v[j] * rstd * gg + bb; xr[64 * j] = o;
            if (ob) ((GAS unsigned long long*)(ob + (size_t)m * D) + F.lane)[64 * j] = (unsigned long long)pk2(o.x, o.y) | ((unsigned long long)pk2(o.z, o.w) << 32); }
    }
}

__device__ __forceinline__ void attn_simple(Frame& F) {
    const int gw = F.vcu * NWAVES + F.wave, NGW = F.G * NWAVES, lane = F.lane;
    for (int task = gw; task < M * 4; task += NGW) {
        const int tok = task >> 2, j = task & 3, b = tok / SEQ, t = tok % SEQ;
        float mrun = -INFINITY, lrun = 0.f, orun = 0.f;
#pragma unroll 1
        for (int g = 0; g < 3; ++g) {
            const int r = (g == 0) ? 1 : (g == 1) ? 4 : 16, head = g * 4 + j;
            const bf16* Kb = F.QKV + (size_t)b * SEQ * QKVW + 768 + head * 64;
            const bf16* Vb = F.QKV + (size_t)b * SEQ * QKVW + 1536 + head * 64;
            const float qd = bf2f(F.QKV[(size_t)tok * QKVW + head * 64 + lane]);
            const int pA = t + r * (lane - 64), pB = t + r * lane, pC = t + r * 64;
            const bool vA = pA >= 0, vB = pB < SEQ, vC = pC < SEQ;
            float sA = 0.f, sB = 0.f;
            {
                const v4u* ka = (const v4u*)(Kb + (size_t)(vA ? pA : t) * QKVW);
                const v4u* kb = (const v4u*)(Kb + (size_t)(vB ? pB : t) * QKVW);
#pragma unroll
                for (int d8 = 0; d8 < 8; ++d8) { const v4u a = ka[d8], bq = kb[d8];
                    const unsigned aw[4] = {a.x, a.y, a.z, a.w}, bw[4] = {bq.x, bq.y, bq.z, bq.w};
#pragma unroll
                    for (int e = 0; e < 4; ++e) { const float q0 = rdlane(qd, d8 * 8 + 2 * e), q1 = rdlane(qd, d8 * 8 + 2 * e + 1);
                        sA += q0 * __builtin_bit_cast(float, aw[e] << 16) + q1 * __builtin_bit_cast(float, aw[e] & 0xffff0000u);
                        sB += q0 * __builtin_bit_cast(float, bw[e] << 16) + q1 * __builtin_bit_cast(float, bw[e] & 0xffff0000u); } }
            }
            float sC = wave_sum(qd * bf2f(Kb[(size_t)(vC ? pC : t) * QKVW + lane]));
            sA += F.rel_bias[T5B[g][lane] * 12 + head]; sB += F.rel_bias[T5B[g][lane + 64] * 12 + head]; sC += F.rel_bias[T5B[g][128] * 12 + head];
            if (!vA) sA = -1e30f; if (!vB) sB = -1e30f; if (!vC) sC = -1e30f;
            const float mg = fmaxf(wave_max(fmaxf(sA, sB)), sC);
            const float mnew = fmaxf(mrun, mg), sc = __expf(mrun - mnew);
            const float pa = vA ? __expf(sA - mnew) : 0.f, pb = vB ? __expf(sB - mnew) : 0.f, pc = vC ? __expf(sC - mnew) : 0.f;
            lrun = lrun * sc + wave_sum(pa + pb) + pc; orun *= sc; mrun = mnew;
#pragma unroll 8
            for (int kk = 0; kk < 64; ++kk) { const int pos = t + r * (kk - 64); if (pos >= 0) orun += rdlane(pa, kk) * bf2f(Vb[(size_t)pos * QKVW + lane]); }
#pragma unroll 8
            for (int kk = 0; kk < 64; ++kk) { const int pos = t + r * kk; if (pos < SEQ) orun += rdlane(pb, kk) * bf2f(Vb[(size_t)pos * QKVW + lane]); }
            if (vC) orun += pc * bf2f(Vb[(size_t)pC * QKVW + lane]);
        }
        F.YATTN[(size_t)tok * 256 + j * 64 + lane] = (bf16)f2bf(orun / lrun);
    }
}

__device__ __forceinline__ float log_sigmoid(float z) { return fminf(z, 0.f) - log1pf(__expf(-fabsf(z))); }
__device__ __forceinline__ void gla_decay_cumsum(Frame& F, LAS float* bq, LAS float* lrs, int tok0, int h, int dir) {
    const int tid = F.tid;
    const float* wl = dir ? F.w_lr_b : F.w_lr_f; const float* bl = dir ? F.b_lr_b : F.b_lr_f;
    for (int i = tid; i < 64 * 16; i += 512) lrs[i] = F.LR[(size_t)(tok0 + (i >> 4)) * 32 + dir * 16 + (i & 15)];
    __syncthreads();
    {
        const int d = tid & 63, cg = tid >> 6;
        float w[16];
#pragma unroll
        for (int r = 0; r < 16; ++r) w[r] = wl[r * 256 + h * 64 + d];
        const float bias = bl[h * 64 + d];
#pragma unroll
        for (int i = 0; i < 8; ++i) { const int c = cg * 8 + i; float z = bias;
#pragma unroll
            for (int r = 0; r < 16; ++r) z += lrs[c * 16 + r] * w[r];
            bq[c * 64 + d] = log_sigmoid(z) * (1.0f / 16.0f); }
    }
    __syncthreads();
    if (tid < 64) { float s = 0.f;
        if (dir == 0) { for (int c = 0; c < 64; ++c) { s += bq[c * 64 + tid]; bq[c * 64 + tid] = s; } }
        else { for (int c = 63; c >= 0; --c) { s += bq[c * 64 + tid]; bq[c * 64 + tid] = s; } } }
    __syncthreads();
}
__device__ __forceinline__ void gla_kv_simple(Frame& F) {
    LAS float* bq = (LAS float*)(F.lds);
    LAS float* kd = bq + 4096;
    LAS float* vs = kd + 4096;
    LAS float* lrs = vs + 8192;
    const int tid = F.tid;
    for (int u = F.vcu; u < 2048; u += F.G) {
        const int n = u & 31, dir = (u >> 5) & 1, h = (u >> 6) & 3, b = u >> 8;
        const int tok0 = b * SEQ + n * 64;
        gla_decay_cumsum(F, bq, lrs, tok0, h, dir);
        for (int i = tid; i < 4096; i += 512) { const int c = i >> 6, d = i & 63; const float bref = dir ? bq[d] : bq[63 * 64 + d];
            kd[i] = bf2f(F.GQK[(size_t)(tok0 + c) * 512 + 256 + h * 64 + d]) * __expf(bref - bq[i]); }
        for (int i = tid; i < 8192; i += 512) { const int c = i >> 7, v = i & 127; vs[i] = bf2f(F.GV[(size_t)(tok0 + c) * 512 + h * 128 + v]); }
        if (tid < 64) F.DEC[(size_t)u * 64 + tid] = __expf(dir ? bq[tid] : bq[63 * 64 + tid]);
        __syncthreads();
        {
            const int d = tid >> 3, vg = tid & 7; float acc[16];
#pragma unroll
            for (int i = 0; i < 16; ++i) acc[i] = 0.f;
            for (int c = 0; c < 64; ++c) { const float kk = kd[c * 64 + d];
#pragma unroll
                for (int i = 0; i < 16; ++i) acc[i] += kk * vs[c * 128 + vg * 16 + i]; }
            bf16* o = F.STATES + (size_t)u * 8192 + d * 128 + vg * 16;
#pragma unroll
            for (int i = 0; i < 16; i += 2) *(unsigned*)(o + i) = pk2(acc[i], acc[i + 1]);
        }
        __syncthreads();
    }
}
__device__ __forceinline__ void gla_scan(Frame& F) {
    const int gt = F.vcu * 512 + F.tid, NGT = F.G * 512;
    for (int it = gt; it < 64 * 2048; it += NGT) {
        const int chain = it >> 11, e4 = it & 2047, d = (e4 * 4) >> 7, dir = chain & 1;
        unsigned long long kvw[32]; float dc[32];
#pragma unroll
        for (int k = 0; k < 32; ++k) { const int u = chain * 32 + (dir ? 31 - k : k); kvw[k] = *((const unsigned long long*)(F.STATES + (size_t)u * 8192) + e4); dc[k] = F.DEC[(size_t)u * 64 + d]; }
        float s0 = 0.f, s1 = 0.f, s2 = 0.f, s3 = 0.f;
#pragma unroll
        for (int k = 0; k < 32; ++k) { const int u = chain * 32 + (dir ? 31 - k : k);
            *((unsigned long long*)(F.STATES + (size_t)u * 8192) + e4) = (unsigned long long)pk2(s0, s1) | ((unsigned long long)pk2(s2, s3) << 32);
            const unsigned lo = (unsigned)kvw[k], hi = (unsigned)(kvw[k] >> 32);
            s0 = dc[k] * s0 + __builtin_bit_cast(float, lo << 16); s1 = dc[k] * s1 + __builtin_bit_cast(float, lo & 0xffff0000u);
            s2 = dc[k] * s2 + __builtin_bit_cast(float, hi << 16); s3 = dc[k] * s3 + __builtin_bit_cast(float, hi & 0xffff0000u); }
    }
}
__device__ __forceinline__ void gla_out_simple(Frame& F) {
    LAS float* bq = (LAS float*)(F.lds);
    LAS float* qi = bq + 4096;
    LAS float* ki = qi + 4096;
    LAS float* A  = ki + 4096;
    LAS float* vs = A + 4096;
    LAS float* Sp = vs + 8192;
    const int tid = F.tid;
    for (int u = F.vcu; u < 1024; u += F.G) {
        const int n = u & 31, h = (u >> 5) & 3, b = u >> 7;
        const int tok0 = b * SEQ + n * 64;
        const int c = tid >> 3, vg = tid & 7;
        float o[16];
#pragma unroll
        for (int i = 0; i < 16; ++i) o[i] = 0.f;
        for (int i = tid; i < 8192; i += 512) { const int cc = i >> 7, v = i & 127; vs[i] = bf2f(F.GV[(size_t)(tok0 + cc) * 512 + h * 128 + v]); }
#pragma unroll 1
        for (int dir = 0; dir < 2; ++dir) {
            gla_decay_cumsum(F, bq, Sp, tok0, h, dir);
            for (int i = tid; i < 4096; i += 512) { const int cc = i >> 6, d = i & 63; const float bb = bq[i];
                qi[i] = bf2f(F.GQK[(size_t)(tok0 + cc) * 512 + h * 64 + d]) * __expf(bb);
                ki[i] = bf2f(F.GQK[(size_t)(tok0 + cc) * 512 + 256 + h * 64 + d]) * __expf(-bb); }
            const size_t su = (size_t)(((b * 4 + h) * 2 + dir) * 32 + n) * 8192;
            for (int i = tid; i < 8192; i += 512) Sp[i] = bf2f(F.STATES[su + i]);
            __syncthreads();
            {
                float a[8];
#pragma unroll
                for (int i = 0; i < 8; ++i) a[i] = 0.f;
                for (int d = 0; d < 64; ++d) { const float q = qi[c * 64 + d];
#pragma unroll
                    for (int i = 0; i < 8; ++i) a[i] += q * ki[(vg * 8 + i) * 64 + d]; }
#pragma unroll
                for (int i = 0; i < 8; ++i) { const int s = vg * 8 + i; const bool keep = dir ? (s > c) : (s <= c); A[c * 64 + s] = keep ? a[i] : 0.f; }
            }
            __syncthreads();
            for (int s = 0; s < 64; ++s) { const float a = A[c * 64 + s], q = qi[c * 64 + s];
#pragma unroll
                for (int i = 0; i < 16; ++i) o[i] += a * vs[s * 128 + vg * 16 + i] + q * Sp[s * 128 + vg * 16 + i]; }
            __syncthreads();
        }
        float ss = 0.f;
#pragma unroll
        for (int i = 0; i < 16; ++i) ss += o[i] * o[i];
        ss += __shfl_xor(ss, 1); ss += __shfl_xor(ss, 2); ss += __shfl_xor(ss, 4);
        const float rstd = 1.0f / sqrtf(ss * (1.0f / 128.0f) + NORM_EPS);
        bf16* yo = F.GOUT + (size_t)(tok0 + c) * 512 + h * 128 + vg * 16;
#pragma unroll
        for (int i = 0; i < 16; i += 2) { const float g0 = F.gla_g[h * 128 + vg * 16 + i], g1 = F.gla_g[h * 128 + vg * 16 + i + 1];
            *(unsigned*)(yo + i) = pk2(o[i] * rstd * g0 * bf2f(yo[i]), o[i + 1] * rstd * g1 * bf2f(yo[i + 1])); }
    }
}

struct Args { const float* in[19]; float* out; unsigned char* ws; int ph_lo, ph_hi, li, pad; };
__global__ void __launch_bounds__(NWAVES * 64, 2) fwd_megakernel(Args args) {
    extern __shared__ __attribute__((aligned(16))) unsigned char lds[];
    Frame F;
    F.lds = (LAS unsigned char*)lds;
    F.MISC = (volatile LAS unsigned*)(F.lds + MISC_OFF);
    F.tid = threadIdx.x; F.lane = F.tid & 63; F.wave = __builtin_amdgcn_readfirstlane(F.tid >> 6);
    F.G = gridDim.x; { const int bx = blockIdx.x; F.vcu = (F.G % 8 == 0) ? (bx % 8) * (F.G / 8) + bx / 8 : bx; }
    unsigned char* ws = args.ws;
    F.ctl = (gu32*)(ws + WS_CTL);
    F.x = args.in[0]; F.w_in = args.in[1]; F.rel_bias = args.in[2]; F.w_lr_f = args.in[3]; F.b_lr_f = args.in[4]; F.w_lr_b = args.in[5]; F.b_lr_b = args.in[6]; F.gla_g = args.in[7];
    F.w_ab = args.in[8]; F.w_gb = args.in[9]; F.w_out = args.in[10]; F.ln1_g = args.in[11]; F.ln1_b = args.in[12]; F.w_ff1 = args.in[13]; F.b_ff1 = args.in[14]; F.w_ff2 = args.in[15]; F.b_ff2 = args.in[16];
    F.ln2_g = args.in[17]; F.ln2_b = args.in[18]; F.out = args.out;
    F.WIN_t = (bf16*)(ws + WS_WIN); F.WAB_t = (bf16*)(ws + WS_WAB); F.WGB_t = (bf16*)(ws + WS_WGB); F.WOUT_t = (bf16*)(ws + WS_WOUT); F.WFF1_t = (bf16*)(ws + WS_WFF1); F.WFF2_t = (bf16*)(ws + WS_WFF2);
    F.XB = (bf16*)(ws + WS_XB); F.QKV = (bf16*)(ws + WS_QKV); F.GQK = (bf16*)(ws + WS_GQK); F.GV = (bf16*)(ws + WS_GV); F.GOUT = (bf16*)(ws + WS_GOUT); F.GATES = (bf16*)(ws + WS_GATES);
    F.YATTN = (bf16*)(ws + WS_YATTN); F.STATES = (bf16*)(ws + WS_STATES); F.MERGED = (bf16*)(ws + WS_MERGED); F.X1B = (bf16*)(ws + WS_X1B); F.HB = (bf16*)(ws + WS_H);
    F.LR = (float*)(ws + WS_LR); F.DEC = (float*)(ws + WS_DEC); F.PART = (float*)(ws + WS_PART);
    for (int u = F.tid; u < (LDS_BYTES - LDSCTL_OFF) / 4; u += NWAVES * 64) ((LAS unsigned*)(F.lds + LDSCTL_OFF))[u] = 0u;
    __syncthreads();
    XcdBarrier bar; bar.bar = (unsigned*)(F.ctl + CW_BAR); bar.x = 0; bar.st = nullptr;
    if (!MK_PER_PHASE) bar = xcd_barrier_post((unsigned*)(F.ctl + CW_BAR), F.MISC + 8);
    const int lo = args.ph_lo, hi = args.ph_hi;
#define IN(k) (lo <= (k) && (k) < hi)
#define SEAM(k) do { if (IN(k) && IN((k) + 1)) xcd_barrier(bar); } while (0)

    if (IN(0)) { p0_prologue(F); } SEAM(0);
    if (IN(1)) {
        pg8::Gemm g{F.XB, F.WIN_t, M, NPROJ, D}; pg8::StaticOrder S; S.init(M, NPROJ, F.G, (int)blockIdx.x);
        pg8::EpiProj E{F.QKV, F.GQK, F.GV, F.GOUT, F.GATES, F.LR};
        pg8::gemm_phase<pg8::EpiProj, pg8::StaticOrder, true, true>(F.lds + RING_OFF, g, S, E);
    } SEAM(1);
    if (IN(2)) { gla_kv_simple(F); attn_simple(F); } SEAM(2);
    if (IN(3)) { gla_scan(F); } SEAM(3);
    if (IN(4)) { gla_out_simple(F); } SEAM(4);
    if (IN(5)) {
        { pg8::Gemm g{F.YATTN, F.WAB_t, M, D, 256}; pg8::StaticOrder S; S.init(M, D, F.G, (int)blockIdx.x);
          pg8::EpiMerge<false> E{F.GATES, 0, F.PART, F.MERGED};
          pg8::gemm_phase<pg8::EpiMerge<false>, pg8::StaticOrder, true, true>(F.lds + RING_OFF, g, S, E); }
        { pg8::Gemm g{F.GOUT, F.WGB_t, M, D, 512}; pg8::StaticOrder S; S.init(M, D, F.G, (int)blockIdx.x);
          pg8::EpiMerge<true> E{F.GATES, 1024, F.PART, F.MERGED};
          pg8::gemm_phase<pg8::EpiMerge<true>, pg8::StaticOrder, true, true>(F.lds + RING_OFF, g, S, E); }
    } SEAM(5);
    if (IN(6)) {
        pg8::Gemm g{F.MERGED, F.WOUT_t, M, D, D}; pg8::StaticOrder S; S.init(M, D, F.G, (int)blockIdx.x);
        pg8::EpiResF32 E{F.x, F.out, nullptr, ALPHA};
        pg8::gemm_phase<pg8::EpiResF32, pg8::StaticOrder, true, true>(F.lds + RING_OFF, g, S, E);
    } SEAM(6);
    if (IN(7)) { ln_rows(F, F.out, F.ln1_g, F.ln1_b, F.X1B); } SEAM(7);
    if (IN(8)) {
        pg8::Gemm g{F.X1B, F.WFF1_t, M, FF, D}; pg8::StaticOrder S; S.init(M, FF, F.G, (int)blockIdx.x);
        pg8::EpiSqRelu E{F.HB, FF, F.b_ff1};
        pg8::gemm_phase<pg8::EpiSqRelu, pg8::StaticOrder, true, true>(F.lds + RING_OFF, g, S, E);
    } SEAM(8);
    if (IN(9)) {
        pg8::Gemm g{F.HB, F.WFF2_t, M, D, FF}; pg8::StaticOrder S; S.init(M, D, F.G, (int)blockIdx.x);
        pg8::EpiResF32 E{F.out, F.out, F.b_ff2, ALPHA};
        pg8::gemm_phase<pg8::EpiResF32, pg8::StaticOrder, true, true>(F.lds + RING_OFF, g, S, E);
    } SEAM(9);
    if (IN(10)) { ln_rows(F, F.out, F.ln2_g, F.ln2_b, nullptr); }
#undef IN
#undef SEAM
}

extern "C" void kernel_launch(void* const* d_in, const int* in_sizes, int n_in, void* d_out, int out_size, void* d_ws, size_t ws_size, hipStream_t stream) {
    static int grid = 0;
    if (grid == 0) {
        if (n_in != 19 || in_sizes[0] != M * D || out_size != M * D || ws_size < WS_END) { fprintf(stderr, "kernel_launch: unexpected shapes (n_in %d, in0 %d, out %d, ws %zu); nothing launched\n", n_in, n_in > 0 ? in_sizes[0] : -1, out_size, ws_size); grid = -1; return; }
        int dev = 0, cus = 0, per_cu = 0;
        if (hipGetDevice(&dev) != hipSuccess || hipDeviceGetAttribute(&cus, hipDeviceAttributeMultiprocessorCount, dev) != hipSuccess) { grid = -1; return; }
        if (hipFuncSetAttribute((const void*)fwd_megakernel, hipFuncAttributeMaxDynamicSharedMemorySize, LDS_BYTES) != hipSuccess) { fprintf(stderr, "kernel_launch: hipFuncSetAttribute failed\n"); grid = -1; return; }
        if (hipOccupancyMaxActiveBlocksPerMultiprocessor(&per_cu, (const void*)fwd_megakernel, NWAVES * 64, LDS_BYTES) != hipSuccess || per_cu < 1) { fprintf(stderr, "kernel_launch: occupancy query reports %d blocks per CU; nothing launched\n", per_cu); (void)hipGetLastError(); grid = -1; return; }
        grid = cus;
    }
    if (grid < 0) return;
    (void)hipMemsetAsync((char*)d_ws + WS_CTL, 0, CTL_ZERO_BYTES, stream);
    Args a{};
    for (int i = 0; i < 19; ++i) a.in[i] = (const float*)d_in[i];
    a.out = (float*)d_out; a.ws = (unsigned char*)d_ws;
#if MK_PER_PHASE
    for (int p = 0; p < NPH; ++p) { a.ph_lo = p; a.ph_hi = p + 1; a.li = p; hipLaunchKernelGGL(fwd_megakernel, dim3(grid), dim3(NWAVES * 64), LDS_BYTES, stream, a); }
#else
    a.ph_lo = 0; a.ph_hi = NPH; a.li = 0;
    hipLaunchKernelGGL(fwd_megakernel, dim3(grid), dim3(NWAVES * 64), LDS_BYTES, stream, a);
#endif
    const hipError_t le = hipPeekAtLastError();
    if (le != hipSuccess) fprintf(stderr, "kernel_launch: launch failed: %s\n", hipGetErrorName(le));
}
```

```cpp
#define MK_PER_PHASE 0
#include <hip/hip_runtime.h>
#include <cstdio>
#include <cstdint>
#include <cmath>
namespace pg8 {
#define PG8_LAS __attribute__((address_space(3)))
typedef unsigned short bf16_t;
typedef short bf16x8 __attribute__((ext_vector_type(8)));
typedef float f32x4 __attribute__((ext_vector_type(4)));
typedef unsigned u32x4 __attribute__((ext_vector_type(4)));
constexpr int BM = 256, BK = 64, HALF = 128, HTB = HALF * BK * 2  , STAGE_BYTES = 8 * HTB, NXCD = 8, WGM = 8;

__host__ __device__ __forceinline__ int lds_byte(int r, int c) { const int st = (r >> 4) * 2 + (c >> 5), rr = r & 15, cc = c & 31, ob = rr * 64 + cc * 2; return st * 1024 + (ob ^ (((ob >> 9) & 1) << 5)); }
__host__ __device__ __forceinline__ void stage_rc(int b, int& R, int& C) { const int st = b / 1024, sb = b % 1024, swz = sb ^ (((sb >> 9) & 1) << 5); R = (st >> 1) * 16 + swz / 64; C = (st & 1) * 32 + (swz % 64) / 2; }
__host__ __device__ __forceinline__ int perm32(int rho) { const int n = rho >> 4, i = rho & 15; return 8 * (i >> 2) + 4 * n + (i & 3); }

struct Unit { int pm, pn; };
struct Gemm { const bf16_t* A; const bf16_t* Bt; int M, N, K; };

struct StaticOrder {
    int nM, nN, nwg, G, c;
    __host__ __device__ void init(int M, int N, int G_, int c_) { nM = M / BM; nN = N / BM; nwg = nM * nN; G = G_; c = c_; }
    __host__ __device__ bool next(int i, Unit& u) const {
        const long L = (long)i * G + c; if (L >= nwg) return false;
        int wgid = (int)L; { const int q = nwg / NXCD, r = nwg % NXCD, xcd = wgid % NXCD, off = wgid / NXCD; wgid = (xcd < r ? xcd * (q + 1) : r * (q + 1) + (xcd - r) * q) + off; }
        const int nig = WGM * nN, gid = wgid / nig, fm = gid * WGM, gsz = (nM - fm) < WGM ? (nM - fm) : WGM;
        u.pm = fm + ((wgid % nig) % gsz); u.pn = (wgid % nig) / gsz; return true;
    }
    __device__ __forceinline__ void a_ready(const Unit&) const {}
    __device__ __forceinline__ void done(const Unit&) const {}
};

__device__ __forceinline__ unsigned cvt_pk_bf16(float lo, float hi) { unsigned r; asm volatile("v_cvt_pk_bf16_f32 %0, %1, %2" : "=v"(r) : "v"(lo), "v"(hi)); return r; }
typedef float f32x2 __attribute__((ext_vector_type(2)));
__device__ __forceinline__ float bf2f(unsigned short h) { return __builtin_bit_cast(float, (unsigned)h << 16); }
__device__ __forceinline__ float sigmoidf_fast(float v) { return __builtin_amdgcn_rcpf(1.0f + __expf(-v)); }
struct EpiProj {
    static constexpr bool PERM = true, AFTER_DRAIN = false;
    bf16_t *QKV, *GQK, *GV, *GOUT, *GATES; float* LR;
    __device__ __forceinline__ void operator()(const f32x4 (&acc)[2][2][4][2], const Unit& u, int wr, int wc, int fr, int fq) const {
        const int pn = u.pn, row0 = u.pm * BM + wr * 64 + fr, c0 = wc * 32 + 8 * fq;
        if (pn == 15) {
            if (wc == 0) {
#pragma unroll
                for (int ai = 0; ai < 2; ++ai)
#pragma unroll
                    for (int m = 0; m < 4; ++m) { float* p = LR + (size_t)(row0 + ai * HALF + m * 16) * 32 + 8 * fq; *(f32x4*)p = acc[ai][0][m][0]; *(f32x4*)(p + 4) = acc[ai][0][m][1]; }
            }
            return;
        }
        bf16_t* base; int ldc, colt, op;
        if (pn < 9) { base = QKV; ldc = 2304; colt = pn * 256; op = pn < 3 ? 1 : 0; }
        else if (pn < 11) { base = GQK; ldc = 512; colt = (pn - 9) * 256; op = pn == 9 ? 1 : 0; }
        else if (pn < 13) { base = GV; ldc = 512; colt = (pn - 11) * 256; op = 0; }
        else if (pn < 15) { base = GOUT; ldc = 512; colt = (pn - 13) * 256; op = 2; }
        else { base = GATES; ldc = 2048; colt = (pn - 16) * 256; op = 3; }
#pragma unroll
        for (int ai = 0; ai < 2; ++ai)
#pragma unroll
            for (int m = 0; m < 4; ++m) { bf16_t* rowp = base + (size_t)(row0 + ai * HALF + m * 16) * ldc + colt + c0;
#pragma unroll
                for (int bj = 0; bj < 2; ++bj) { f32x4 v0 = acc[ai][bj][m][0], v1 = acc[ai][bj][m][1];
                    if (op == 1) { v0 = v0 * 0.125f; v1 = v1 * 0.125f; }
                    else if (op == 2) {
#pragma unroll
                        for (int e = 0; e < 4; ++e) { v0[e] = v0[e] * sigmoidf_fast(v0[e]); v1[e] = v1[e] * sigmoidf_fast(v1[e]); } }
                    else if (op == 3) {
#pragma unroll
                        for (int e = 0; e < 4; ++e) { v0[e] = sigmoidf_fast(v0[e]); v1[e] = sigmoidf_fast(v1[e]); } }
                    u32x4 w; w.x = cvt_pk_bf16(v0[0], v0[1]); w.y = cvt_pk_bf16(v0[2], v0[3]); w.z = cvt_pk_bf16(v1[0], v1[1]); w.w = cvt_pk_bf16(v1[2], v1[3]);
                    *(u32x4*)(rowp + bj * HALF) = w; } }
    }
};
struct EpiSqRelu {
    static constexpr bool PERM = true, AFTER_DRAIN = false;
    bf16_t* O; int ldc; const float* bias;
    __device__ __forceinline__ void operator()(const f32x4 (&acc)[2][2][4][2], const Unit& u, int wr, int wc, int fr, int fq) const {
        const int row0 = u.pm * BM + wr * 64 + fr, col0 = u.pn * BM + wc * 32 + 8 * fq;
        f32x4 bv[2][2];
#pragma unroll
        for (int bj = 0; bj < 2; ++bj)
#pragma unroll
            for (int n = 0; n < 2; ++n) bv[bj][n] = *(const f32x4*)(bias + col0 + bj * HALF + 4 * n);
#pragma unroll
        for (int ai = 0; ai < 2; ++ai)
#pragma unroll
            for (int m = 0; m < 4; ++m) { bf16_t* rowp = O + (size_t)(row0 + ai * HALF + m * 16) * ldc + col0;
#pragma unroll
                for (int bj = 0; bj < 2; ++bj) { f32x4 v0 = acc[ai][bj][m][0] + bv[bj][0], v1 = acc[ai][bj][m][1] + bv[bj][1];
#pragma unroll
                    for (int e = 0; e < 4; ++e) { const float a = fmaxf(v0[e], 0.f), b = fmaxf(v1[e], 0.f); v0[e] = a * a; v1[e] = b * b; }
                    u32x4 w; w.x = cvt_pk_bf16(v0[0], v0[1]); w.y = cvt_pk_bf16(v0[2], v0[3]); w.z = cvt_pk_bf16(v1[0], v1[1]); w.w = cvt_pk_bf16(v1[2], v1[3]);
                    *(u32x4*)(rowp + bj * HALF) = w; } }
    }
};
template <bool SECOND> struct EpiMerge {
    static constexpr bool PERM = true, AFTER_DRAIN = false;
    const bf16_t* gates; int goff; float* part; bf16_t* merged;
    __device__ __forceinline__ void operator()(const f32x4 (&acc)[2][2][4][2], const Unit& u, int wr, int wc, int fr, int fq) const {
        const int row0 = u.pm * BM + wr * 64 + fr, col0 = u.pn * BM + wc * 32 + 8 * fq;
#pragma unroll
        for (int ai = 0; ai < 2; ++ai)
#pragma unroll
            for (int m = 0; m < 4; ++m) { const size_t row = (size_t)(row0 + ai * HALF + m * 16);
#pragma unroll
                for (int bj = 0; bj < 2; ++bj) { const int col = col0 + bj * HALF;
                    const u32x4 gw = *(const u32x4*)(gates + row * 2048 + goff + col);
                    f32x4 g0, g1; g0[0] = __builtin_bit_cast(float, gw.x << 16); g0[1] = __builtin_bit_cast(float, gw.x & 0xffff0000u); g0[2] = __builtin_bit_cast(float, gw.y << 16); g0[3] = __builtin_bit_cast(float, gw.y & 0xffff0000u);
                    g1[0] = __builtin_bit_cast(float, gw.z << 16); g1[1] = __builtin_bit_cast(float, gw.z & 0xffff0000u); g1[2] = __builtin_bit_cast(float, gw.w << 16); g1[3] = __builtin_bit_cast(float, gw.w & 0xffff0000u);
                    f32x4 v0 = acc[ai][bj][m][0] * g0, v1 = acc[ai][bj][m][1] * g1; float* pp = part + row * 1024 + col;
                    if (!SECOND) { *(f32x4*)pp = v0; *(f32x4*)(pp + 4) = v1; }
                    else { v0 = v0 + *(const f32x4*)pp; v1 = v1 + *(const f32x4*)(pp + 4);
                        u32x4 w; w.x = cvt_pk_bf16(v0[0], v0[1]); w.y = cvt_pk_bf16(v0[2], v0[3]); w.z = cvt_pk_bf16(v1[0], v1[1]); w.w = cvt_pk_bf16(v1[2], v1[3]);
                        *(u32x4*)(merged + row * 1024 + col) = w; } }
                asm volatile("" ::: "memory"); }
    }
};
struct EpiResF32 {
    static constexpr bool PERM = true, AFTER_DRAIN = false;
    const float* base; float* out; const float* bias; float alpha;
    __device__ __forceinline__ void operator()(const f32x4 (&acc)[2][2][4][2], const Unit& u, int wr, int wc, int fr, int fq) const {
        const int row0 = u.pm * BM + wr * 64 + fr, col0 = u.pn * BM + wc * 32 + 8 * fq;
        f32x4 bv[2][2];
#pragma unroll
        for (int bj = 0; bj < 2; ++bj)
#pragma unroll
            for (int n = 0; n < 2; ++n) bv[bj][n] = bias ? *(const f32x4*)(bias + col0 + bj * HALF + 4 * n) : (f32x4){0.f, 0.f, 0.f, 0.f};
#pragma unroll
        for (int ai = 0; ai < 2; ++ai)
#pragma unroll
            for (int m = 0; m < 4; ++m) { const size_t off = (size_t)(row0 + ai * HALF + m * 16) * 1024 + col0;
#pragma unroll
                for (int bj = 0; bj < 2; ++bj) { const f32x4 b0 = *(const f32x4*)(base + off + bj * HALF), b1 = *(const f32x4*)(base + off + bj * HALF + 4);
                    *(f32x4*)(out + off + bj * HALF) = b0 * alpha + acc[ai][bj][m][0] + bv[bj][0]; *(f32x4*)(out + off + bj * HALF + 4) = b1 * alpha + acc[ai][bj][m][1] + bv[bj][1]; }
                asm volatile("" ::: "memory"); }
    }
};
template <class Epi, class Sched, bool ALIGN_EPI = false, bool SP2 = false>
__device__ __forceinline__ void gemm_phase(PG8_LAS unsigned char* lds, const Gemm g, const Sched& S, const Epi& E) {
    int tid_ = threadIdx.x; asm volatile("" : "+v"(tid_));
    const int tid = tid_, wid = __builtin_amdgcn_readfirstlane(tid >> 6), lane = tid & 63, wr = wid >> 2, wc = wid & 3, fr = lane & 15, fq = lane >> 4;
    const int K = g.K, nt = K / BK;
    unsigned voffA[2], voffB[2];
#pragma unroll
    for (int i = 0; i < 2; ++i) { int R, C; stage_rc(tid * 16 + i * 8192, R, C); const int Rb = Epi::PERM ? ((R & ~31) + perm32(R & 31)) : R;
        voffA[i] = (unsigned)(R * K + C) * 2u; voffB[i] = (unsigned)(Rb * K + C) * 2u; }
    const size_t kstep = (size_t)(BK * 2);
    const size_t hstep = (size_t)HALF * K * 2;
    const size_t tstep = 2 * hstep;
    const unsigned ldsw = (unsigned)wid * 1024u;
    const int aoff = lds_byte(wr * 64 + fr, fq * 8), boff = lds_byte(wc * 32 + fr, fq * 8);
#define PG8_SA(b, h) (((b) * 2 + (h)) * HTB)
#define PG8_SB(b, h) ((4 + (b) * 2 + (h)) * HTB)
#define PG8_STAGE(bufoff, gbase, voff) do { _Pragma("unroll") for (int _i = 0; _i < 2; ++_i) \
        __builtin_amdgcn_global_load_lds((const unsigned*)((const char*)(gbase) + (voff)[_i]), (PG8_LAS unsigned*)(lds + (bufoff) + ldsw + _i * 8192), 16, 0, 0); } while (0)
#define PG8_LDA(dst, b, h) do { _Pragma("unroll") for (int m = 0; m < 4; ++m) _Pragma("unroll") for (int k = 0; k < 2; ++k) dst[m][k] = *(const PG8_LAS bf16x8*)(lds + PG8_SA(b, h) + aoff + m * 2048 + k * 1024); } while (0)
#define PG8_LDB(dst, b, h) do { _Pragma("unroll") for (int n = 0; n < 2; ++n) _Pragma("unroll") for (int k = 0; k < 2; ++k) dst[n][k] = *(const PG8_LAS bf16x8*)(lds + PG8_SB(b, h) + boff + n * 2048 + k * 1024); } while (0)
#define PG8_MMA(ai, bj, At, Bt) do { __builtin_amdgcn_s_setprio(1); _Pragma("unroll") for (int m = 0; m < 4; ++m) _Pragma("unroll") for (int n = 0; n < 2; ++n) _Pragma("unroll") for (int k = 0; k < 2; ++k) \
        acc[ai][bj][m][n] = __builtin_amdgcn_mfma_f32_16x16x32_bf16(Bt[n][k], At[m][k], acc[ai][bj][m][n], 0, 0, 0); __builtin_amdgcn_s_setprio(0); } while (0)
#define PG8_WAIT_V(n) asm volatile("s_waitcnt vmcnt(" #n ")" ::: "memory")
#define PG8_WAIT_L(n) asm volatile("s_waitcnt lgkmcnt(" #n ")" ::: "memory")
#define PG8_BAR __builtin_amdgcn_s_barrier()
#define PG8_SCHED __builtin_amdgcn_sched_barrier(0)
    Unit cur, nxt; int ui = 0;
    if (!S.next(0, cur)) return;
    f32x4 acc[2][2][4][2];
#pragma unroll
    for (int a = 0; a < 2; ++a)
#pragma unroll
        for (int b = 0; b < 2; ++b)
#pragma unroll
            for (int m = 0; m < 4; ++m)
#pragma unroll
                for (int n = 0; n < 2; ++n) acc[a][b][m][n] = (f32x4){0.f, 0.f, 0.f, 0.f};
    bf16x8 At[4][2], B0[2][2], B1[2][2];
    const char* cA = (const char*)g.A + (size_t)cur.pm * tstep; const char* cB = (const char*)g.Bt + (size_t)cur.pn * tstep;
    S.a_ready(cur);
    if constexpr (SP2) {
        PG8_STAGE(PG8_SB(0, 0), cB, voffB); PG8_STAGE(PG8_SB(0, 1), cB + hstep, voffB); PG8_STAGE(PG8_SA(0, 0), cA, voffA); PG8_STAGE(PG8_SA(0, 1), cA + hstep, voffA);
        if (wr == 1) PG8_BAR;
        PG8_WAIT_V(2); PG8_BAR;
        PG8_STAGE(PG8_SB(1, 0), cB + kstep, voffB); PG8_STAGE(PG8_SA(1, 0), cA + kstep, voffA); PG8_STAGE(PG8_SB(1, 1), cB + hstep + kstep, voffB);
        PG8_WAIT_V(6); PG8_BAR;
    } else {
        PG8_STAGE(PG8_SB(0, 0), cB, voffB); PG8_STAGE(PG8_SA(0, 0), cA, voffA); PG8_STAGE(PG8_SB(0, 1), cB + hstep, voffB); PG8_STAGE(PG8_SA(0, 1), cA + hstep, voffA);
        if (wr == 1) PG8_BAR;
        PG8_WAIT_V(4); PG8_BAR;
        PG8_STAGE(PG8_SB(1, 0), cB + kstep, voffB); PG8_STAGE(PG8_SA(1, 0), cA + kstep, voffA); PG8_STAGE(PG8_SB(1, 1), cB + hstep + kstep, voffB);
        PG8_WAIT_V(6); PG8_BAR;
    }
    for (;;) {
        const bool has_next = S.next(ui + 1, nxt);
        const char* nA = has_next ? (const char*)g.A + (size_t)nxt.pm * tstep : cA; const char* nB = has_next ? (const char*)g.Bt + (size_t)nxt.pn * tstep : cB;
        for (int t = 0; t < nt; t += 2) {
            const bool last = (t == nt - 2);
            const char* a1 = cA + (size_t)(t + 1) * kstep;
            const char* a2 = last ? nA : cA + (size_t)(t + 2) * kstep; const char* b2 = last ? nB : cB + (size_t)(t + 2) * kstep;
            const char* a3 = a2 + kstep; const char* b3 = b2 + kstep;
            if (last && has_next) S.a_ready(nxt);
            if constexpr (SP2) {
            PG8_LDB(B0, 0, 0); PG8_LDB(B1, 0, 1); PG8_SCHED; PG8_LDA(At, 0, 0); PG8_STAGE(PG8_SA(1, 1), a1 + hstep, voffA);
            PG8_WAIT_V(8); PG8_WAIT_L(0); PG8_BAR; PG8_MMA(0, 0, At, B0); PG8_MMA(0, 1, At, B1); PG8_BAR; PG8_SCHED;
            PG8_LDA(At, 0, 1); PG8_STAGE(PG8_SB(0, 0), b2, voffB); PG8_STAGE(PG8_SB(0, 1), b2 + hstep, voffB); PG8_STAGE(PG8_SA(0, 0), a2, voffA);
            PG8_WAIT_V(8); PG8_WAIT_L(0); PG8_BAR; PG8_MMA(1, 0, At, B0); PG8_MMA(1, 1, At, B1); PG8_BAR; PG8_SCHED;
            PG8_LDB(B0, 1, 0); PG8_LDB(B1, 1, 1); PG8_SCHED; PG8_LDA(At, 1, 0); PG8_STAGE(PG8_SA(0, 1), a2 + hstep, voffA);
            PG8_WAIT_V(8); PG8_WAIT_L(0); PG8_BAR; PG8_MMA(0, 0, At, B0); PG8_MMA(0, 1, At, B1); PG8_BAR; PG8_SCHED;
            PG8_LDA(At, 1, 1); PG8_STAGE(PG8_SB(1, 0), b3, voffB); PG8_STAGE(PG8_SB(1, 1), b3 + hstep, voffB); PG8_STAGE(PG8_SA(1, 0), a3, voffA);
            PG8_WAIT_V(8); PG8_WAIT_L(0); PG8_BAR; PG8_MMA(1, 0, At, B0); PG8_MMA(1, 1, At, B1); PG8_BAR; PG8_SCHED;
            } else {
            PG8_LDB(B0, 0, 0); PG8_SCHED; PG8_LDA(At, 0, 0); PG8_STAGE(PG8_SA(1, 1), a1 + hstep, voffA);
            PG8_WAIT_L(8); PG8_BAR; PG8_WAIT_L(0); PG8_MMA(0, 0, At, B0); PG8_BAR; PG8_SCHED;
            PG8_LDB(B1, 0, 1); PG8_STAGE(PG8_SB(0, 0), b2, voffB);
            PG8_BAR; PG8_WAIT_L(0); PG8_MMA(0, 1, At, B1); PG8_BAR;
            PG8_LDA(At, 0, 1); PG8_STAGE(PG8_SA(0, 0), a2, voffA);
            PG8_BAR; PG8_WAIT_L(0); PG8_MMA(1, 0, At, B0); PG8_BAR; PG8_SCHED;
            PG8_STAGE(PG8_SB(0, 1), b2 + hstep, voffB);
            PG8_WAIT_V(6); PG8_BAR; PG8_MMA(1, 1, At, B1); PG8_BAR;
            PG8_LDB(B0, 1, 0); PG8_SCHED; PG8_LDA(At, 1, 0); PG8_STAGE(PG8_SA(0, 1), a2 + hstep, voffA);
            PG8_WAIT_L(8); PG8_BAR; PG8_WAIT_L(0); PG8_MMA(0, 0, At, B0); PG8_BAR; PG8_SCHED;
            PG8_LDB(B1, 1, 1); PG8_STAGE(PG8_SB(1, 0), b3, voffB);
            PG8_BAR; PG8_WAIT_L(0); PG8_MMA(0, 1, At, B1); PG8_BAR;
            PG8_LDA(At, 1, 1); PG8_STAGE(PG8_SA(1, 0), a3, voffA);
            PG8_BAR; PG8_WAIT_L(0); PG8_MMA(1, 0, At, B0); PG8_BAR; PG8_SCHED;
            PG8_STAGE(PG8_SB(1, 1), b3 + hstep, voffB);
            PG8_WAIT_V(6); PG8_BAR; PG8_MMA(1, 1, At, B1); PG8_BAR;
            }
        }
        if constexpr (ALIGN_EPI) { if (wr == 0) PG8_BAR; }
        if constexpr (!Epi::AFTER_DRAIN) { E(acc, cur, wr, wc, fr, fq); S.done(cur); }
        if (!has_next) break;
#pragma unroll
        for (int a = 0; a < 2; ++a)
#pragma unroll
            for (int b = 0; b < 2; ++b)
#pragma unroll
                for (int m = 0; m < 4; ++m)
#pragma unroll
                    for (int n = 0; n < 2; ++n) acc[a][b][m][n] = (f32x4){0.f, 0.f, 0.f, 0.f};
        cur = nxt; cA = nA; cB = nB; ++ui;
        if constexpr (ALIGN_EPI) { if (wr == 1) PG8_BAR; }
    }
    PG8_WAIT_V(0);
    if constexpr (!ALIGN_EPI) { if (wr == 0) PG8_BAR; }
    PG8_BAR;
    if constexpr (Epi::AFTER_DRAIN) { E.fused(acc, cur, wr, wc, fr, fq, lds, wid, lane); S.done(cur); }
#undef PG8_SA
#undef PG8_SB
#undef PG8_STAGE
#undef PG8_LDA
#undef PG8_LDB
#undef PG8_MMA
#undef PG8_WAIT_V
#undef PG8_WAIT_L
#undef PG8_BAR
#undef PG8_SCHED
}
}
#define PG8_SP2 true
#define PG8_ALIGN true
#define GAS __attribute__((address_space(1)))
#define LAS __attribute__((address_space(3)))
typedef unsigned short bf16;
typedef unsigned v4u __attribute__((ext_vector_type(4)));
typedef float f32x4 __attribute__((ext_vector_type(4)));
typedef short bf16x8 __attribute__((ext_vector_type(8)));
typedef GAS unsigned gu32;
typedef GAS unsigned long long gu64;
#define RLX_AGENT __ATOMIC_RELAXED, __HIP_MEMORY_SCOPE_AGENT
#define LDS_WAIT() asm volatile("s_waitcnt lgkmcnt(0)" ::: "memory")
#define VM_WAIT() asm volatile("s_waitcnt vmcnt(0)" ::: "memory")
__device__ __forceinline__ unsigned long long rt() { return __builtin_amdgcn_s_memrealtime(); }
__device__ __forceinline__ unsigned f2bf(float f) { unsigned u = __builtin_bit_cast(unsigned, f); return (u + 0x7fffu + ((u >> 16) & 1u)) >> 16; }
__device__ __forceinline__ unsigned pk2(float lo, float hi) { return f2bf(lo) | (f2bf(hi) << 16); }

#define XB_TMO      128
#define XB_XCNT(j)  (256  + 64 * (j))
#define XB_XSUB(j)  (1280 + 64 * (j))
#define XB_XGEN(j)  (2304 + 64 * (j))
#define XB_TOP      3328
#define XB_TOPGEN   3392
#define XCD_BAR_WORDS 3456
#define XB_SPIN_CAP (1u << 18)

__device__ __forceinline__ unsigned xb_ld(unsigned* p)              { return __hip_atomic_load(p, __ATOMIC_RELAXED, __HIP_MEMORY_SCOPE_AGENT); }
__device__ __forceinline__ unsigned xb_add(unsigned* p, unsigned v) { return __hip_atomic_fetch_add(p, v, __ATOMIC_RELAXED, __HIP_MEMORY_SCOPE_AGENT); }
__device__ __forceinline__ unsigned xb_xcc_id() { return (unsigned)__builtin_amdgcn_s_getreg((3 << 11) | 20) & 0xFu; }
#define XB_SPIN(cond, bar) do { unsigned _sp = 0; while (cond) { __builtin_amdgcn_s_sleep(1); \
    if ((++_sp & 255u) == 0u) { if (xb_ld(&(bar)[XB_TMO])) break; if (_sp > XB_SPIN_CAP) { atomicAdd(&(bar)[XB_TMO], 1u); break; } } } } while (0)

struct XcdBarrier {
    unsigned* bar; unsigned x;
    volatile LAS unsigned* st;
};

__device__ __forceinline__ XcdBarrier xcd_barrier_post(unsigned* bar, volatile LAS unsigned* st) {
    XcdBarrier b; b.bar = bar; b.x = xb_xcc_id(); b.st = st;
    if (threadIdx.x == 0) (void)xb_add(&bar[XB_XCNT(b.x)], 1u);
    return b;
}
__device__ __forceinline__ void xcd_barrier_complete(unsigned* bar, unsigned x, unsigned& nloc, unsigned& nx) {
    const unsigned G = gridDim.x * gridDim.y * gridDim.z;
    unsigned sum, cnt, mine, sp = 0u;
    for (;;) {
        sum = 0u; cnt = 0u; mine = 0u;
#pragma unroll
        for (unsigned j = 0; j < 16; ++j) { const unsigned c = xb_ld(&bar[XB_XCNT(j)]); sum += c; cnt += (c > 0u) ? 1u : 0u; mine = (j == x) ? c : mine; }
        if (sum == G) break;
        __builtin_amdgcn_s_sleep(1);
        if ((++sp & 255u) == 0u) { if (xb_ld(&bar[XB_TMO])) break; if (sp > XB_SPIN_CAP) { atomicAdd(&bar[XB_TMO], 1u); break; } }
    }
    nloc = mine > 0u ? mine : 1u; nx = cnt > 0u ? cnt : 1u;
}

__device__ __forceinline__ void xcd_barrier(const XcdBarrier& b) {
    asm volatile("s_waitcnt vmcnt(0)" ::: "memory");
    __syncthreads();
    if (threadIdx.x == 0) {
        unsigned* bar = b.bar;
        __builtin_amdgcn_s_waitcnt(0);
        unsigned nloc = b.st[0], nx = b.st[1];
        if (nloc == 0u) { xcd_barrier_complete(bar, b.x, nloc, nx); b.st[0] = nloc; b.st[1] = nx; }
        const unsigned old = xb_add(&bar[XB_XSUB(b.x)], 1u);
        const unsigned gen = old / nloc;
        if (old + 1u == (gen + 1u) * nloc) {
            __builtin_amdgcn_fence(__ATOMIC_RELEASE, "agent");
            asm volatile("s_waitcnt vmcnt(0)" ::: "memory");
            const unsigned og = xb_add(&bar[XB_TOP], 1u);
            const unsigned tg = og / nx;
            if (og + 1u == (tg + 1u) * nx) xb_add(&bar[XB_TOPGEN], 1u);
            else XB_SPIN(xb_ld(&bar[XB_TOPGEN]) == tg, bar);
            __builtin_amdgcn_fence(__ATOMIC_ACQUIRE, "agent");
            xb_add(&bar[XB_XGEN(b.x)], 1u);
            asm volatile("s_waitcnt vmcnt(0)" ::: "memory");
        } else {
            XB_SPIN(xb_ld(&bar[XB_XGEN(b.x)]) == gen, bar);
            __builtin_amdgcn_fence(__ATOMIC_ACQUIRE, "agent");
            asm volatile("s_waitcnt vmcnt(0)" ::: "memory");
        }
    }
    __syncthreads();
}

constexpr int NWAVES = 8;
constexpr int BATCH = 8, SEQ = 2048, D = 1024, M = BATCH * SEQ, FF = 4096;
constexpr int IN_COLS = 5920, NPROJ = 6144, QKVW = 2304;
constexpr float ALPHA = 1.18920711500272106672f;
constexpr float LN_EPS = 1e-5f, NORM_EPS = 1e-6f;
constexpr int NPH = 11;
#ifndef MK_PER_PHASE
#define MK_PER_PHASE 0
#endif

constexpr size_t MiB = 1u << 20;
constexpr size_t WS_CTL = 0, CTL_ZERO_BYTES = 1 * MiB;
constexpr size_t WS_WOUT = 1 * MiB, WS_WAB = 3 * MiB, WS_WGB = 4 * MiB, WS_WFF1 = 5 * MiB, WS_WFF2 = 13 * MiB, WS_WIN = 21 * MiB;
constexpr size_t WS_YATTN = 21 * MiB, WS_DEC = 29 * MiB, WS_LSE = 30 * MiB;
constexpr size_t WS_XB = 33 * MiB;
constexpr size_t WS_STATES = 33 * MiB;
constexpr size_t WS_X1B = 33 * MiB;
constexpr size_t WS_QKV = 65 * MiB;
constexpr size_t WS_GQK = 137 * MiB, WS_GV = 153 * MiB, WS_GOUT = 169 * MiB;
constexpr size_t WS_LR = 185 * MiB;
constexpr size_t WS_GATES = 187 * MiB;
constexpr size_t WS_PART = 65 * MiB;
constexpr size_t WS_MERGED = 129 * MiB;
constexpr size_t WS_H = 65 * MiB;
constexpr size_t WS_END = 251 * MiB;
constexpr int CW_TMO = 0, CW_CODE = 1, CW_BAR = 4096;

constexpr int RING_OFF = 0, RING_BYTES = 131072;
constexpr int LDSCTL_OFF = RING_BYTES, MISC_OFF = LDSCTL_OFF + 320;
constexpr int LDS_BYTES = 147456;

__device__ const unsigned char T5B[3][132] = {
 {11,11,11,11,11,11,11,11,11,11,11,11,11,11,11,10,10,10,10,10,10,10,10,10,10,10,10,10,10,10,10,10,10,10,10,10,10,10,9,9,9,9,9,9,9,9,9,9,9,9,8,8,8,8,8,8,8,7,6,5,4,3,2,1,0,17,18,19,20,21,22,23,24,24,24,24,24,24,24,25,25,25,25,25,25,25,25,25,25,25,25,26,26,26,26,26,26,26,26,26,26,26,26,26,26,26,26,26,26,26,26,26,26,26,27,27,27,27,27,27,27,27,27,27,27,27,27,27,27,0,0,0},
 {13,13,13,13,13,13,13,13,13,13,13,13,13,13,13,13,13,13,13,13,13,13,13,12,12,12,12,12,12,12,12,12,12,12,12,12,12,12,12,12,12,12,11,11,11,11,11,11,11,11,11,11,10,10,10,10,10,10,9,9,9,8,8,4,0,20,24,24,25,25,25,26,26,26,26,26,26,27,27,27,27,27,27,27,27,27,27,28,28,28,28,28,28,28,28,28,28,28,28,28,28,28,28,28,28,28,29,29,29,29,29,29,29,29,29,29,29,29,29,29,29,29,29,29,29,29,29,29,29,0,0,0},
 {15,15,15,15,15,15,15,15,15,15,15,15,15,15,15,15,15,15,15,15,15,15,15,15,15,15,15,15,15,15,14,14,14,14,14,14,14,14,14,14,14,14,14,14,14,13,13,13,13,13,13,13,13,13,12,12,12,12,12,11,11,10,10,9,0,25,26,26,27,27,28,28,28,28,28,29,29,29,29,29,29,29,29,29,30,30,30,30,30,30,30,30,30,30,30,30,30,30,30,31,31,31,31,31,31,31,31,31,31,31,31,31,31,31,31,31,31,31,31,31,31,31,31,31,31,31,31,31,31,0,0,0}};

struct Frame {
    LAS unsigned char* lds;
    volatile LAS unsigned* MISC;
    gu32* ctl;
    int tid, lane, wave;
    int vcu, G;
    const float* x; float* out;
    const float *w_in, *rel_bias, *w_lr_f, *b_lr_f, *w_lr_b, *b_lr_b, *gla_g, *w_ab, *w_gb, *w_out, *ln1_g, *ln1_b, *w_ff1, *b_ff1, *w_ff2, *b_ff2, *ln2_g, *ln2_b;
    bf16 *WIN_t, *WAB_t, *WGB_t, *WOUT_t, *WFF1_t, *WFF2_t;
    bf16 *XB, *QKV, *GQK, *GV, *GOUT, *GATES, *YATTN, *STATES, *MERGED, *X1B, *HB;
    float *LR, *DEC, *PART, *LSE;
};
__device__ __forceinline__ float bf2f(bf16 h) { return __builtin_bit_cast(float, (unsigned)h << 16); }
__device__ __forceinline__ float wave_sum(float v) {
#pragma unroll
    for (int o = 1; o < 64; o <<= 1) v += __shfl_xor(v, o);
    return v;
}
__device__ __forceinline__ float wave_max(float v) {
#pragma unroll
    for (int o = 1; o < 64; o <<= 1) v = fmaxf(v, __shfl_xor(v, o));
    return v;
}
__device__ __forceinline__ float rdlane(float v, int l) { return __builtin_bit_cast(float, __builtin_amdgcn_readlane(__builtin_bit_cast(int, v), l)); }

template <bool REMAP>
__device__ __forceinline__ void p0_transpose_item(const float* W, int K, int N, bf16* WT, LAS float* scr, int item, int lane) {
    const int nblk = N / 32, kb = item / nblk, nb = item % nblk, k0 = 64 * kb, n0 = 32 * nb;
    const int row_off = (REMAP && n0 >= 3872) ? 224 : 0;
#pragma unroll 8
    for (int i = 0; i < 32; ++i) { const int kk = 2 * i + (lane >> 5); scr[kk * 33 + (lane & 31)] = W[(size_t)(k0 + kk) * N + n0 + (lane & 31)]; }
    LDS_WAIT(); asm volatile("" ::: "memory");
    const int c = lane & 7;
#pragma unroll
    for (int j = 0; j < 4; ++j) { const int n = (lane >> 3) + 8 * j; const LAS float* s = scr + (8 * c) * 33 + n;
        v4u o; o.x = pk2(s[0 * 33], s[1 * 33]); o.y = pk2(s[2 * 33], s[3 * 33]); o.z = pk2(s[4 * 33], s[5 * 33]); o.w = pk2(s[6 * 33], s[7 * 33]);
        *(GAS v4u*)(WT + (size_t)(row_off + n0 + n) * K + k0 + 8 * c) = o; }
    LDS_WAIT(); asm volatile("" ::: "memory");
}
__device__ __forceinline__ void p0_prologue(Frame& F) {
    LAS float* scr = (LAS float*)(F.lds + RING_OFF + F.wave * 16384);
    const int gw = F.vcu * NWAVES + F.wave, NGW = F.G * NWAVES;
    constexpr int I_IN = (D / 64) * (IN_COLS / 32), I_AB = (256 / 64) * (D / 32), I_GB = (512 / 64) * (D / 32), I_OUT = (D / 64) * (D / 32), I_1 = (D / 64) * (FF / 32), I_2 = (FF / 64) * (D / 32);
    constexpr int NITEMS = I_IN + I_AB + I_GB + I_OUT + I_1 + I_2;
    for (int it = gw; it < NITEMS; it += NGW) {
        int r = it;
        if (r < I_IN) { p0_transpose_item<true>(F.w_in, D, IN_COLS, F.WIN_t, scr, r, F.lane); continue; } r -= I_IN;
        if (r < I_AB) { p0_transpose_item<false>(F.w_ab, 256, D, F.WAB_t, scr, r, F.lane); continue; } r -= I_AB;
        if (r < I_GB) { p0_transpose_item<false>(F.w_gb, 512, D, F.WGB_t, scr, r, F.lane); continue; } r -= I_GB;
        if (r < I_OUT) { p0_transpose_item<false>(F.w_out, D, D, F.WOUT_t, scr, r, F.lane); continue; } r -= I_OUT;
        if (r < I_1) { p0_transpose_item<false>(F.w_ff1, D, FF, F.WFF1_t, scr, r, F.lane); continue; } r -= I_1;
        p0_transpose_item<false>(F.w_ff2, FF, D, F.WFF2_t, scr, r, F.lane);
    }
    for (int rr = gw; rr < 224; rr += NGW) { GAS v4u* o = (GAS v4u*)(F.WIN_t + (size_t)(3872 + rr) * D) + F.lane; o[0] = (v4u){0u, 0u, 0u, 0u}; o[64] = (v4u){0u, 0u, 0u, 0u}; }
    for (int m = gw; m < M; m += NGW) {
        const GAS f32x4* xr = (const GAS f32x4*)(F.x + (size_t)m * D) + F.lane;
        GAS unsigned long long* o8 = (GAS unsigned long long*)(F.XB + (size_t)m * D) + F.lane;
#pragma unroll
        for (int j = 0; j < 4; ++j) { const f32x4 v = xr[64 * j]; o8[64 * j] = (unsigned long long)pk2(v.x, v.y) | ((unsigned long long)pk2(v.z, v.w) << 32); }
    }
}

__device__ __forceinline__ void ln_rows(Frame& F, float* buf, const float* g, const float* b, bf16* ob) {
    const int gw = F.vcu * NWAVES + F.wave, NGW = F.G * NWAVES;
    for (int m = gw; m < M; m += NGW) {
        GAS f32x4* xr = (GAS f32x4*)(buf + (size_t)m * D) + F.lane;
        f32x4 v[4]; float s = 0.f;
#pragma unroll
        for (int j = 0; j < 4; ++j) { v[j] = xr[64 * j]; s += (v[j].x + v[j].y) + (v[j].z + v[j].w); }
        const float mean = wave_sum(s) * (1.f / D); float s2 = 0.f;
#pragma unroll
        for (int j = 0; j < 4; ++j) { v[j] = v[j] - mean; s2 += (v[j].x * v[j].x + v[j].y * v[j].y) + (v[j].z * v[j].z + v[j].w * v[j].w); }
        const float rstd = 1.f / sqrtf(wave_sum(s2) * (1.f / D) + LN_EPS);
#pragma unroll
        for (int j = 0; j < 4; ++j) { const f32x4 gg = *((const GAS f32x4*)g + F.lane + 64 * j), bb = *((const GAS f32x4*)b + F.lane + 64 * j);
            const f32x4 o = v[j] * rstd * gg + bb; xr[64 * j] = o;
            if (ob) ((GAS unsigned long long*)(ob + (size_t)m * D) + F.lane)[64 * j] = (unsigned long long)pk2(o.x, o.y) | ((unsigned long long)pk2(o.z, o.w) << 32); }
    }
}

__device__ __forceinline__ void attn_simple(Frame& F) {
    const int gw = F.vcu * NWAVES + F.wave, NGW = F.G * NWAVES, lane = F.lane;
    for (int task = gw; task < M * 4; task += NGW) {
        const int tok = task >> 2, j = task & 3, b = tok / SEQ, t = tok % SEQ;
        float mrun = -INFINITY, lrun = 0.f, orun = 0.f;
#pragma unroll 1
        for (int g = 0; g < 3; ++g) {
            const int r = (g == 0) ? 1 : (g == 1) ? 4 : 16, head = g * 4 + j;
            const bf16* Kb = F.QKV + (size_t)b * SEQ * QKVW + 768 + head * 64;
            const bf16* Vb = F.QKV + (size_t)b * SEQ * QKVW + 1536 + head * 64;
            const float qd = bf2f(F.QKV[(size_t)tok * QKVW + head * 64 + lane]);
            const int pA = t + r * (lane - 64), pB = t + r * lane, pC = t + r * 64;
            const bool vA = pA >= 0, vB = pB < SEQ, vC = pC < SEQ;
            float sA = 0.f, sB = 0.f;
            {
                const v4u* ka = (const v4u*)(Kb + (size_t)(vA ? pA : t) * QKVW);
                const v4u* kb = (const v4u*)(Kb + (size_t)(vB ? pB : t) * QKVW);
#pragma unroll
                for (int d8 = 0; d8 < 8; ++d8) { const v4u a = ka[d8], bq = kb[d8];
                    const unsigned aw[4] = {a.x, a.y, a.z, a.w}, bw[4] = {bq.x, bq.y, bq.z, bq.w};
#pragma unroll
                    for (int e = 0; e < 4; ++e) { const float q0 = rdlane(qd, d8 * 8 + 2 * e), q1 = rdlane(qd, d8 * 8 + 2 * e + 1);
                        sA += q0 * __builtin_bit_cast(float, aw[e] << 16) + q1 * __builtin_bit_cast(float, aw[e] & 0xffff0000u);
                        sB += q0 * __builtin_bit_cast(float, bw[e] << 16) + q1 * __builtin_bit_cast(float, bw[e] & 0xffff0000u); } }
            }
            float sC = wave_sum(qd * bf2f(Kb[(size_t)(vC ? pC : t) * QKVW + lane]));
            sA += F.rel_bias[T5B[g][lane] * 12 + head]; sB += F.rel_bias[T5B[g][lane + 64] * 12 + head]; sC += F.rel_bias[T5B[g][128] * 12 + head];
            if (!vA) sA = -1e30f; if (!vB) sB = -1e30f; if (!vC) sC = -1e30f;
            const float mg = fmaxf(wave_max(fmaxf(sA, sB)), sC);
            const float mnew = fmaxf(mrun, mg), sc = __expf(mrun - mnew);
            const float pa = vA ? __expf(sA - mnew) : 0.f, pb = vB ? __expf(sB - mnew) : 0.f, pc = vC ? __expf(sC - mnew) : 0.f;
            lrun = lrun * sc + wave_sum(pa + pb) + pc; orun *= sc; mrun = mnew;
#pragma unroll 8
            for (int kk = 0; kk < 64; ++kk) { const int pos = t + r * (kk - 64); if (pos >= 0) orun += rdlane(pa, kk) * bf2f(Vb[(size_t)pos * QKVW + lane]); }
#pragma unroll 8
            for (int kk = 0; kk < 64; ++kk) { const int pos = t + r * kk; if (pos < SEQ) orun += rdlane(pb, kk) * bf2f(Vb[(size_t)pos * QKVW + lane]); }
            if (vC) orun += pc * bf2f(Vb[(size_t)pC * QKVW + lane]);
        }
        F.YATTN[(size_t)tok * 256 + j * 64 + lane] = (bf16)f2bf(orun / lrun);
    }
}


typedef short v4i16_t __attribute__((ext_vector_type(4)));
__device__ __forceinline__ v4i16_t lds_tr16(LAS const unsigned char* p) { return __builtin_amdgcn_ds_read_tr16_b64_v4i16((LAS v4i16_t*)p); }
__device__ __forceinline__ unsigned cvtpk(float lo, float hi) { unsigned r; asm volatile("v_cvt_pk_bf16_f32 %0, %1, %2" : "=v"(r) : "v"(lo), "v"(hi)); return r; }
__device__ __forceinline__ void attn_mfma(Frame& F) {
    LAS unsigned char* Ks = F.lds;
    LAS unsigned char* Vs = F.lds + 32768;
    LAS float* bt = (LAS float*)(F.lds + 65536);
    const int tid = F.tid, lane = F.lane, w = F.wave, l15 = lane & 15, g4 = lane >> 4;
    for (int u = F.vcu; u < 1536; u += F.G) {
        const int g = u >> 9, rem = u & 511, b = rem >> 6, hh = (rem >> 4) & 3, idx = rem & 15;
        const int r = 1 << (2 * g), lognb = 4 - 2 * g, c = idx >> lognb, nb = idx & ((1 << lognb) - 1), L = SEQ >> (2 * g), head = g * 4 + hh;
        bf16* base = F.QKV + (size_t)b * SEQ * QKVW + head * 64;
        if (tid < 160) { const int rel = tid - 80; bt[tid] = (rel >= -64 && rel <= 64) ? F.rel_bias[T5B[g][rel + 64] * 12 + head] : -1e30f; }
        const int m0 = 128 * nb - 64;
#pragma unroll
        for (int i = 0; i < 4; ++i) {
            const int piece = w * 4 + i, row = piece * 8 + (lane >> 3);
            int m = m0 + row; m = m < 0 ? 0 : (m > L - 1 ? L - 1 : m);
            const int chunk = (lane & 7) ^ (lane >> 3);
            const bf16* src = base + (size_t)(m * r + c) * QKVW + chunk * 8;
            __builtin_amdgcn_global_load_lds((const unsigned*)(src + 768), (LAS unsigned*)(Ks + piece * 1024), 16, 0, 0);
            __builtin_amdgcn_global_load_lds((const unsigned*)(src + 1536), (LAS unsigned*)(Vs + piece * 1024), 16, 0, 0);
        }
        const int mq0 = 128 * nb + 16 * w;
        bf16* qrow = base + (size_t)((mq0 + l15) * r + c) * QKVW;
        bf16x8 qf[2];
        qf[0] = *(const bf16x8*)(qrow + g4 * 8); qf[1] = *(const bf16x8*)(qrow + 32 + g4 * 8);
        asm volatile("s_waitcnt vmcnt(0)" ::: "memory");
        __syncthreads();
        f32x4 s[9];
#pragma unroll
        for (int t = 0; t < 9; ++t) {
            const int row = 16 * w + 16 * t + l15;
            f32x4 acc = (f32x4){0.f, 0.f, 0.f, 0.f};
#pragma unroll
            for (int ks = 0; ks < 2; ++ks) {
                const bf16x8 kf = *(const LAS bf16x8*)(Ks + row * 128 + (((4 * ks + g4) ^ (lane & 7)) << 4));
                acc = __builtin_amdgcn_mfma_f32_16x16x32_bf16(kf, qf[ks], acc, 0, 0, 0);
            }
            s[t] = acc;
        }
        const int lo = (64 - mq0) > 0 ? (64 - mq0) : 0, hi = (L + 64 - mq0) < 144 ? (L + 64 - mq0) : 144;
        float mx = -INFINITY;
#pragma unroll
        for (int t = 0; t < 9; ++t)
#pragma unroll
            for (int i = 0; i < 4; ++i) { const int kk = 16 * t + 4 * g4 + i; float v = s[t][i] + bt[kk + 16 - l15]; v = (kk < lo || kk >= hi) ? -1e30f : v; s[t][i] = v; mx = fmaxf(mx, v); }
        mx = fmaxf(mx, __shfl_xor(mx, 16)); mx = fmaxf(mx, __shfl_xor(mx, 32));
        float lsum = 0.f;
#pragma unroll
        for (int t = 0; t < 9; ++t)
#pragma unroll
            for (int i = 0; i < 4; ++i) { const float p = __expf(s[t][i] - mx); s[t][i] = p; lsum += p; }
        lsum += __shfl_xor(lsum, 16); lsum += __shfl_xor(lsum, 32);
        f32x4 o[4];
#pragma unroll
        for (int dt = 0; dt < 4; ++dt) o[dt] = (f32x4){0.f, 0.f, 0.f, 0.f};
        const int vr = 4 * g4 + (l15 >> 2), vsw = (4 * (g4 & 1) + (l15 >> 2)), vch = (lane & 3) >> 1, vo8 = 8 * (lane & 1);
#pragma unroll
        for (int ks = 0; ks < 5; ++ks) {
            const int t0 = 2 * ks, t1 = (2 * ks + 1 < 9) ? 2 * ks + 1 : 8;
            v4u pw; pw.x = cvtpk(s[t0][0], s[t0][1]); pw.y = cvtpk(s[t0][2], s[t0][3]);
            if (2 * ks + 1 < 9) { pw.z = cvtpk(s[t1][0], s[t1][1]); pw.w = cvtpk(s[t1][2], s[t1][3]); } else { pw.z = 0u; pw.w = 0u; }
            const bf16x8 pf = __builtin_bit_cast(bf16x8, pw);
            const int ra = 16 * w + 16 * t0 + vr, rb = 16 * w + 16 * t1 + vr;
#pragma unroll
            for (int dt = 0; dt < 4; ++dt) {
                const int sw = ((2 * dt + vch) ^ vsw) << 4;
                const v4i16_t va = lds_tr16(Vs + ra * 128 + sw + vo8), vb = lds_tr16(Vs + rb * 128 + sw + vo8);
                const bf16x8 vf = (bf16x8){va[0], va[1], va[2], va[3], vb[0], vb[1], vb[2], vb[3]};
                o[dt] = __builtin_amdgcn_mfma_f32_16x16x32_bf16(vf, pf, o[dt], 0, 0, 0);
            }
        }
        const float inv = 1.0f / lsum;
#pragma unroll
        for (int dt = 0; dt < 4; ++dt) { const unsigned long long wv = (unsigned long long)cvtpk(o[dt][0] * inv, o[dt][1] * inv) | ((unsigned long long)cvtpk(o[dt][2] * inv, o[dt][3] * inv) << 32);
            *(unsigned long long*)(qrow + 16 * dt + 4 * g4) = wv; }
        if (g4 == 0) F.LSE[((size_t)g * M + (size_t)b * SEQ + (size_t)((mq0 + l15) * r + c)) * 4 + hh] = mx + __logf(lsum);
        __syncthreads();
    }
}
__device__ __forceinline__ void attn_combine(Frame& F) {
    const int gw = F.vcu * NWAVES + F.wave, NGW = F.G * NWAVES, lane = F.lane, hh = lane >> 4, d4 = (lane & 15) * 4;
    for (int tok = gw; tok < M; tok += NGW) {
        float ls[3], mxl = -INFINITY;
#pragma unroll
        for (int g = 0; g < 3; ++g) { ls[g] = F.LSE[((size_t)g * M + tok) * 4 + hh]; mxl = fmaxf(mxl, ls[g]); }
        float wsum = 0.f, y0 = 0.f, y1 = 0.f, y2 = 0.f, y3 = 0.f;
#pragma unroll
        for (int g = 0; g < 3; ++g) { const float wg = __expf(ls[g] - mxl); wsum += wg;
            const unsigned long long v = *(const unsigned long long*)(F.QKV + (size_t)tok * QKVW + (g * 4 + hh) * 64 + d4);
            const unsigned lo = (unsigned)v, hi = (unsigned)(v >> 32);
            y0 += wg * __builtin_bit_cast(float, lo << 16); y1 += wg * __builtin_bit_cast(float, lo & 0xffff0000u); y2 += wg * __builtin_bit_cast(float, hi << 16); y3 += wg * __builtin_bit_cast(float, hi & 0xffff0000u); }
        const float iw = 1.0f / wsum;
        *(unsigned long long*)(F.YATTN + (size_t)tok * 256 + hh * 64 + d4) = (unsigned long long)pk2(y0 * iw, y1 * iw) | ((unsigned long long)pk2(y2 * iw, y3 * iw) << 32);
    }
}

__device__ __forceinline__ float log_sigmoid(float z) { return fminf(z, 0.f) - log1pf(__expf(-fabsf(z))); }
__device__ __forceinline__ void gla_decay_cumsum(Frame& F, LAS float* bq, LAS float* lrs, int tok0, int h, int dir) {
    const int tid = F.tid;
    const float* wl = dir ? F.w_lr_b : F.w_lr_f; const float* bl = dir ? F.b_lr_b : F.b_lr_f;
    for (int i = tid; i < 64 * 16; i += 512) lrs[i] = F.LR[(size_t)(tok0 + (i >> 4)) * 32 + dir * 16 + (i & 15)];
    __syncthreads();
    {
        const int d = tid & 63, cg = tid >> 6;
        float w[16];
#pragma unroll
        for (int r = 0; r < 16; ++r) w[r] = wl[r * 256 + h * 64 + d];
        const float bias = bl[h * 64 + d];
#pragma unroll
        for (int i = 0; i < 8; ++i) { const int c = cg * 8 + i; float z = bias;
#pragma unroll
            for (int r = 0; r < 16; ++r) z += lrs[c * 16 + r] * w[r];
            bq[c * 64 + d] = log_sigmoid(z) * (1.0f / 16.0f); }
    }
    __syncthreads();
    if (tid < 64) { float s = 0.f;
        if (dir == 0) { for (int c = 0; c < 64; ++c) { s += bq[c * 64 + tid]; bq[c * 64 + tid] = s; } }
        else { for (int c = 63; c >= 0; --c) { s += bq[c * 64 + tid]; bq[c * 64 + tid] = s; } } }
    __syncthreads();
}
__device__ __forceinline__ void gla_kv_simple(Frame& F) {
    LAS float* bq = (LAS float*)(F.lds);
    LAS float* kd = bq + 4096;
    LAS float* vs = kd + 4096;
    LAS float* lrs = vs + 8192;
    const int tid = F.tid;
    for (int u = F.vcu; u < 2048; u += F.G) {
        const int n = u & 31, dir = (u >> 5) & 1, h = (u >> 6) & 3, b = u >> 8;
        const int tok0 = b * SEQ + n * 64;
        gla_decay_cumsum(F, bq, lrs, tok0, h, dir);
        for (int i = tid; i < 4096; i += 512) { const int c = i >> 6, d = i & 63; const float bref = dir ? bq[d] : bq[63 * 64 + d];
            kd[i] = bf2f(F.GQK[(size_t)(tok0 + c) * 512 + 256 + h * 64 + d]) * __expf(bref - bq[i]); }
        for (int i = tid; i < 8192; i += 512) { const int c = i >> 7, v = i & 127; vs[i] = bf2f(F.GV[(size_t)(tok0 + c) * 512 + h * 128 + v]); }
        if (tid < 64) F.DEC[(size_t)u * 64 + tid] = __expf(dir ? bq[tid] : bq[63 * 64 + tid]);
        __syncthreads();
        {
            const int d = tid >> 3, vg = tid & 7; float acc[16];
#pragma unroll
            for (int i = 0; i < 16; ++i) acc[i] = 0.f;
            for (int c = 0; c < 64; ++c) { const float kk = kd[c * 64 + d];
#pragma unroll
                for (int i = 0; i < 16; ++i) acc[i] += kk * vs[c * 128 + vg * 16 + i]; }
            bf16* o = F.STATES + (size_t)u * 8192 + d * 128 + vg * 16;
#pragma unroll
            for (int i = 0; i < 16; i += 2) *(unsigned*)(o + i) = pk2(acc[i], acc[i + 1]);
        }
        __syncthreads();
    }
}
__device__ __forceinline__ void gla_scan(Frame& F) {
    const int gt = F.vcu * 512 + F.tid, NGT = F.G * 512;
    for (int it = gt; it < 64 * 2048; it += NGT) {
        const int chain = it >> 11, e4 = it & 2047, d = (e4 * 4) >> 7, dir = chain & 1;
        unsigned long long kvw[32]; float dc[32];
#pragma unroll
        for (int k = 0; k < 32; ++k) { const int u = chain * 32 + (dir ? 31 - k : k); kvw[k] = *((const unsigned long long*)(F.STATES + (size_t)u * 8192) + e4); dc[k] = F.DEC[(size_t)u * 64 + d]; }
        float s0 = 0.f, s1 = 0.f, s2 = 0.f, s3 = 0.f;
#pragma unroll
        for (int k = 0; k < 32; ++k) { const int u = chain * 32 + (dir ? 31 - k : k);
            *((unsigned long long*)(F.STATES + (size_t)u * 8192) + e4) = (unsigned long long)pk2(s0, s1) | ((unsigned long long)pk2(s2, s3) << 32);
            const unsigned lo = (unsigned)kvw[k], hi = (unsigned)(kvw[k] >> 32);
            s0 = dc[k] * s0 + __builtin_bit_cast(float, lo << 16); s1 = dc[k] * s1 + __builtin_bit_cast(float, lo & 0xffff0000u);
            s2 = dc[k] * s2 + __builtin_bit_cast(float, hi << 16); s3 = dc[k] * s3 + __builtin_bit_cast(float, hi & 0xffff0000u); }
    }
}
__device__ __forceinline__ void gla_out_simple(Frame& F) {
    LAS float* bq = (LAS float*)(F.lds);
    LAS float* qi = bq + 4096;
    LAS float* ki = qi + 4096;
    LAS float* A  = ki + 4096;
    LAS float* vs = A + 4096;
    LAS float* Sp = vs + 8192;
    const int tid = F.tid;
    for (int u = F.vcu; u < 1024; u += F.G) {
        const int n = u & 31, h = (u >> 5) & 3, b = u >> 7;
        const int tok0 = b * SEQ + n * 64;
        const int c = tid >> 3, vg = tid & 7;
        float o[16];
#pragma unroll
        for (int i = 0; i < 16; ++i) o[i] = 0.f;
        for (int i = tid; i < 8192; i += 512) { const int cc = i >> 7, v = i & 127; vs[i] = bf2f(F.GV[(size_t)(tok0 + cc) * 512 + h * 128 + v]); }
#pragma unroll 1
        for (int dir = 0; dir < 2; ++dir) {
            gla_decay_cumsum(F, bq, Sp, tok0, h, dir);
            for (int i = tid; i < 4096; i += 512) { const int cc = i >> 6, d = i & 63; const float bb = bq[i];
                qi[i] = bf2f(F.GQK[(size_t)(tok0 + cc) * 512 + h * 64 + d]) * __expf(bb);
                ki[i] = bf2f(F.GQK[(size_t)(tok0 + cc) * 512 + 256 + h * 64 + d]) * __expf(-bb); }
            const size_t su = (size_t)(((b * 4 + h) * 2 + dir) * 32 + n) * 8192;
            for (int i = tid; i < 8192; i += 512) Sp[i] = bf2f(F.STATES[su + i]);
            __syncthreads();
            {
                float a[8];
#pragma unroll
                for (int i = 0; i < 8; ++i) a[i] = 0.f;
                for (int d = 0; d < 64; ++d) { const float q = qi[c * 64 + d];
#pragma unroll
                    for (int i = 0; i < 8; ++i) a[i] += q * ki[(vg * 8 + i) * 64 + d]; }
#pragma unroll
                for (int i = 0; i < 8; ++i) { const int s = vg * 8 + i; const bool keep = dir ? (s > c) : (s <= c); A[c * 64 + s] = keep ? a[i] : 0.f; }
            }
            __syncthreads();
            for (int s = 0; s < 64; ++s) { const float a = A[c * 64 + s], q = qi[c * 64 + s];
#pragma unroll
                for (int i = 0; i < 16; ++i) o[i] += a * vs[s * 128 + vg * 16 + i] + q * Sp[s * 128 + vg * 16 + i]; }
            __syncthreads();
        }
        float ss = 0.f;
#pragma unroll
        for (int i = 0; i < 16; ++i) ss += o[i] * o[i];
        ss += __shfl_xor(ss, 1); ss += __shfl_xor(ss, 2); ss += __shfl_xor(ss, 4);
        const float rstd = 1.0f / sqrtf(ss * (1.0f / 128.0f) + NORM_EPS);
        bf16* yo = F.GOUT + (size_t)(tok0 + c) * 512 + h * 128 + vg * 16;
#pragma unroll
        for (int i = 0; i < 16; i += 2) { const float g0 = F.gla_g[h * 128 + vg * 16 + i], g1 = F.gla_g[h * 128 + vg * 16 + i + 1];
            *(unsigned*)(yo + i) = pk2(o[i] * rstd * g0 * bf2f(yo[i]), o[i + 1] * rstd * g1 * bf2f(yo[i + 1])); }
    }
}

struct Args { const float* in[19]; float* out; unsigned char* ws; int ph_lo, ph_hi, li, pad; };
__global__ void __launch_bounds__(NWAVES * 64, 2) fwd_megakernel(Args args) {
    extern __shared__ __attribute__((aligned(16))) unsigned char lds[];
    Frame F;
    F.lds = (LAS unsigned char*)lds;
    F.MISC = (volatile LAS unsigned*)(F.lds + MISC_OFF);
    F.tid = threadIdx.x; F.lane = F.tid & 63; F.wave = __builtin_amdgcn_readfirstlane(F.tid >> 6);
    F.G = gridDim.x; { const int bx = blockIdx.x; F.vcu = (F.G % 8 == 0) ? (bx % 8) * (F.G / 8) + bx / 8 : bx; }
    unsigned char* ws = args.ws;
    F.ctl = (gu32*)(ws + WS_CTL);
    F.x = args.in[0]; F.w_in = args.in[1]; F.rel_bias = args.in[2]; F.w_lr_f = args.in[3]; F.b_lr_f = args.in[4]; F.w_lr_b = args.in[5]; F.b_lr_b = args.in[6]; F.gla_g = args.in[7];
    F.w_ab = args.in[8]; F.w_gb = args.in[9]; F.w_out = args.in[10]; F.ln1_g = args.in[11]; F.ln1_b = args.in[12]; F.w_ff1 = args.in[13]; F.b_ff1 = args.in[14]; F.w_ff2 = args.in[15]; F.b_ff2 = args.in[16];
    F.ln2_g = args.in[17]; F.ln2_b = args.in[18]; F.out = args.out;
    F.WIN_t = (bf16*)(ws + WS_WIN); F.WAB_t = (bf16*)(ws + WS_WAB); F.WGB_t = (bf16*)(ws + WS_WGB); F.WOUT_t = (bf16*)(ws + WS_WOUT); F.WFF1_t = (bf16*)(ws + WS_WFF1); F.WFF2_t = (bf16*)(ws + WS_WFF2);
    F.XB = (bf16*)(ws + WS_XB); F.QKV = (bf16*)(ws + WS_QKV); F.GQK = (bf16*)(ws + WS_GQK); F.GV = (bf16*)(ws + WS_GV); F.GOUT = (bf16*)(ws + WS_GOUT); F.GATES = (bf16*)(ws + WS_GATES);
    F.YATTN = (bf16*)(ws + WS_YATTN); F.STATES = (bf16*)(ws + WS_STATES); F.MERGED = (bf16*)(ws + WS_MERGED); F.X1B = (bf16*)(ws + WS_X1B); F.HB = (bf16*)(ws + WS_H);
    F.LR = (float*)(ws + WS_LR); F.DEC = (float*)(ws + WS_DEC); F.PART = (float*)(ws + WS_PART); F.LSE = (float*)(ws + WS_LSE);
    for (int u = F.tid; u < (LDS_BYTES - LDSCTL_OFF) / 4; u += NWAVES * 64) ((LAS unsigned*)(F.lds + LDSCTL_OFF))[u] = 0u;
    __syncthreads();
    XcdBarrier bar; bar.bar = (unsigned*)(F.ctl + CW_BAR); bar.x = 0; bar.st = nullptr;
    if (!MK_PER_PHASE) bar = xcd_barrier_post((unsigned*)(F.ctl + CW_BAR), F.MISC + 8);
    const int lo = args.ph_lo, hi = args.ph_hi;
#define IN(k) (lo <= (k) && (k) < hi)
#define SEAM(k) do { if (IN(k) && IN((k) + 1)) xcd_barrier(bar); } while (0)

    if (IN(0)) { p0_prologue(F); } SEAM(0);
    if (IN(1)) {
        pg8::Gemm g{F.XB, F.WIN_t, M, NPROJ, D}; pg8::StaticOrder S; S.init(M, NPROJ, F.G, (int)blockIdx.x);
        pg8::EpiProj E{F.QKV, F.GQK, F.GV, F.GOUT, F.GATES, F.LR};
        pg8::gemm_phase<pg8::EpiProj, pg8::StaticOrder, true, true>(F.lds + RING_OFF, g, S, E);
    } SEAM(1);
    if (IN(2)) { attn_mfma(F); gla_kv_simple(F); } SEAM(2);
    if (IN(3)) { gla_scan(F); attn_combine(F); } SEAM(3);
    if (IN(4)) { gla_out_simple(F); } SEAM(4);
    if (IN(5)) {
        { pg8::Gemm g{F.YATTN, F.WAB_t, M, D, 256}; pg8::StaticOrder S; S.init(M, D, F.G, (int)blockIdx.x);
          pg8::EpiMerge<false> E{F.GATES, 0, F.PART, F.MERGED};
          pg8::gemm_phase<pg8::EpiMerge<false>, pg8::StaticOrder, true, true>(F.lds + RING_OFF, g, S, E); }
        { pg8::Gemm g{F.GOUT, F.WGB_t, M, D, 512}; pg8::StaticOrder S; S.init(M, D, F.G, (int)blockIdx.x);
          pg8::EpiMerge<true> E{F.GATES, 1024, F.PART, F.MERGED};
          pg8::gemm_phase<pg8::EpiMerge<true>, pg8::StaticOrder, true, true>(F.lds + RING_OFF, g, S, E); }
    } SEAM(5);
    if (IN(6)) {
        pg8::Gemm g{F.MERGED, F.WOUT_t, M, D, D}; pg8::StaticOrder S; S.init(M, D, F.G, (int)blockIdx.x);
        pg8::EpiResF32 E{F.x, F.out, nullptr, ALPHA};
        pg8::gemm_phase<pg8::EpiResF32, pg8::StaticOrder, true, true>(F.lds + RING_OFF, g, S, E);
    } SEAM(6);
    if (IN(7)) { ln_rows(F, F.out, F.ln1_g, F.ln1_b, F.X1B); } SEAM(7);
    if (IN(8)) {
        pg8::Gemm g{F.X1B, F.WFF1_t, M, FF, D}; pg8::StaticOrder S; S.init(M, FF, F.G, (int)blockIdx.x);
        pg8::EpiSqRelu E{F.HB, FF, F.b_ff1};
        pg8::gemm_phase<pg8::EpiSqRelu, pg8::StaticOrder, true, true>(F.lds + RING_OFF, g, S, E);
    } SEAM(8);
    if (IN(9)) {
        pg8::Gemm g{F.HB, F.WFF2_t, M, D, FF}; pg8::StaticOrder S; S.init(M, D, F.G, (int)blockIdx.x);
        pg8::EpiResF32 E{F.out, F.out, F.b_ff2, ALPHA};
        pg8::gemm_phase<pg8::EpiResF32, pg8::StaticOrder, true, true>(F.lds + RING_OFF, g, S, E);
    } SEAM(9);
    if (IN(10)) { ln_rows(F, F.out, F.ln2_g, F.ln2_b, nullptr); }
#undef IN
#undef SEAM
}

extern "C" void kernel_launch(void* const* d_in, const int* in_sizes, int n_in, void* d_out, int out_size, void* d_ws, size_t ws_size, hipStream_t stream) {
    static int grid = 0;
    if (grid == 0) {
        if (n_in != 19 || in_sizes[0] != M * D || out_size != M * D || ws_size < WS_END) { fprintf(stderr, "kernel_launch: unexpected shapes (n_in %d, in0 %d, out %d, ws %zu); nothing launched\n", n_in, n_in > 0 ? in_sizes[0] : -1, out_size, ws_size); grid = -1; return; }
        int dev = 0, cus = 0, per_cu = 0;
        if (hipGetDevice(&dev) != hipSuccess || hipDeviceGetAttribute(&cus, hipDeviceAttributeMultiprocessorCount, dev) != hipSuccess) { grid = -1; return; }
        if (hipFuncSetAttribute((const void*)fwd_megakernel, hipFuncAttributeMaxDynamicSharedMemorySize, LDS_BYTES) != hipSuccess) { fprintf(stderr, "kernel_launch: hipFuncSetAttribute failed\n"); grid = -1; return; }
        if (hipOccupancyMaxActiveBlocksPerMultiprocessor(&per_cu, (const void*)fwd_megakernel, NWAVES * 64, LDS_BYTES) != hipSuccess || per_cu < 1) { fprintf(stderr, "kernel_launch: occupancy query reports %d blocks per CU; nothing launched\n", per_cu); (void)hipGetLastError(); grid = -1; return; }
        grid = cus;
    }
    if (grid < 0) return;
    (void)hipMemsetAsync((char*)d_ws + WS_CTL, 0, CTL_ZERO_BYTES, stream);
    Args a{};
    for (int i = 0; i < 19; ++i) a.in[i] = (const float*)d_in[i];
    a.out = (float*)d_out; a.ws = (unsigned char*)d_ws;
#if MK_PER_PHASE
    for (int p = 0; p < NPH; ++p) { a.ph_lo = p; a.ph_hi = p + 1; a.li = p; hipLaunchKernelGGL(fwd_megakernel, dim3(grid), dim3(NWAVES * 64), LDS_BYTES, stream, a); }
#else
    a.ph_lo = 0; a.ph_hi = NPH; a.li = 0;
    hipLaunchKernelGGL(fwd_megakernel, dim3(grid), dim3(NWAVES * 64), LDS_BYTES, stream, a);
#endif
    const hipError_t le = hipPeekAtLastError();
    if (le != hipSuccess) fprintf(stderr, "kernel_launch: launch failed: %s\n", hipGetErrorName(le));
}
```

```cpp
#define MK_PER_PHASE 0
#include <hip/hip_runtime.h>
#include <cstdio>
#include <cstdint>
#include <cmath>
namespace pg8 {
#define PG8_LAS __attribute__((address_space(3)))
typedef unsigned short bf16_t;
typedef short bf16x8 __attribute__((ext_vector_type(8)));
typedef float f32x4 __attribute__((ext_vector_type(4)));
typedef unsigned u32x4 __attribute__((ext_vector_type(4)));
constexpr int BM = 256, BK = 64, HALF = 128, HTB = HALF * BK * 2  , STAGE_BYTES = 8 * HTB, NXCD = 8, WGM = 8;

__host__ __device__ __forceinline__ int lds_byte(int r, int c) { const int st = (r >> 4) * 2 + (c >> 5), rr = r & 15, cc = c & 31, ob = rr * 64 + cc * 2; return st * 1024 + (ob ^ (((ob >> 9) & 1) << 5)); }
__host__ __device__ __forceinline__ void stage_rc(int b, int& R, int& C) { const int st = b / 1024, sb = b % 1024, swz = sb ^ (((sb >> 9) & 1) << 5); R = (st >> 1) * 16 + swz / 64; C = (st & 1) * 32 + (swz % 64) / 2; }
__host__ __device__ __forceinline__ int perm32(int rho) { const int n = rho >> 4, i = rho & 15; return 8 * (i >> 2) + 4 * n + (i & 3); }

struct Unit { int pm, pn; };
struct Gemm { const bf16_t* A; const bf16_t* Bt; int M, N, K; };

struct StaticOrder {
    int nM, nN, nwg, G, c;
    __host__ __device__ void init(int M, int N, int G_, int c_) { nM = M / BM; nN = N / BM; nwg = nM * nN; G = G_; c = c_; }
    __host__ __device__ bool next(int i, Unit& u) const {
        const long L = (long)i * G + c; if (L >= nwg) return false;
        int wgid = (int)L; { const int q = nwg / NXCD, r = nwg % NXCD, xcd = wgid % NXCD, off = wgid / NXCD; wgid = (xcd < r ? xcd * (q + 1) : r * (q + 1) + (xcd - r) * q) + off; }
        const int nig = WGM * nN, gid = wgid / nig, fm = gid * WGM, gsz = (nM - fm) < WGM ? (nM - fm) : WGM;
        u.pm = fm + ((wgid % nig) % gsz); u.pn = (wgid % nig) / gsz; return true;
    }
    __device__ __forceinline__ void a_ready(const Unit&) const {}
    __device__ __forceinline__ void done(const Unit&) const {}
};

__device__ __forceinline__ unsigned cvt_pk_bf16(float lo, float hi) { unsigned r; asm volatile("v_cvt_pk_bf16_f32 %0, %1, %2" : "=v"(r) : "v"(lo), "v"(hi)); return r; }
typedef float f32x2 __attribute__((ext_vector_type(2)));
__device__ __forceinline__ float bf2f(unsigned short h) { return __builtin_bit_cast(float, (unsigned)h << 16); }
__device__ __forceinline__ float sigmoidf_fast(float v) { return __builtin_amdgcn_rcpf(1.0f + __expf(-v)); }
struct EpiProj {
    static constexpr bool PERM = true, AFTER_DRAIN = false;
    bf16_t *QKV, *GQK, *GV, *GOUT, *GATES; float* LR;
    __device__ __forceinline__ void operator()(const f32x4 (&acc)[2][2][4][2], const Unit& u, int wr, int wc, int fr, int fq) const {
        const int pn = u.pn, row0 = u.pm * BM + wr * 64 + fr, c0 = wc * 32 + 8 * fq;
        if (pn == 15) {
            if (wc == 0) {
#pragma unroll
                for (int ai = 0; ai < 2; ++ai)
#pragma unroll
                    for (int m = 0; m < 4; ++m) { float* p = LR + (size_t)(row0 + ai * HALF + m * 16) * 32 + 8 * fq; *(f32x4*)p = acc[ai][0][m][0]; *(f32x4*)(p + 4) = acc[ai][0][m][1]; }
            }
            return;
        }
        bf16_t* base; int ldc, colt, op;
        if (pn < 9) { base = QKV; ldc = 2304; colt = pn * 256; op = pn < 3 ? 1 : 0; }
        else if (pn < 11) { base = GQK; ldc = 512; colt = (pn - 9) * 256; op = pn == 9 ? 1 : 0; }
        else if (pn < 13) { base = GV; ldc = 512; colt = (pn - 11) * 256; op = 0; }
        else if (pn < 15) { base = GOUT; ldc = 512; colt = (pn - 13) * 256; op = 2; }
        else { base = GATES; ldc = 2048; colt = (pn - 16) * 256; op = 3; }
#pragma unroll
        for (int ai = 0; ai < 2; ++ai)
#pragma unroll
            for (int m = 0; m < 4; ++m) { bf16_t* rowp = base + (size_t)(row0 + ai * HALF + m * 16) * ldc + colt + c0;
#pragma unroll
                for (int bj = 0; bj < 2; ++bj) { f32x4 v0 = acc[ai][bj][m][0], v1 = acc[ai][bj][m][1];
                    if (op == 1) { v0 = v0 * 0.125f; v1 = v1 * 0.125f; }
                    else if (op == 2) {
#pragma unroll
                        for (int e = 0; e < 4; ++e) { v0[e] = v0[e] * sigmoidf_fast(v0[e]); v1[e] = v1[e] * sigmoidf_fast(v1[e]); } }
                    else if (op == 3) {
#pragma unroll
                        for (int e = 0; e < 4; ++e) { v0[e] = sigmoidf_fast(v0[e]); v1[e] = sigmoidf_fast(v1[e]); } }
                    u32x4 w; w.x = cvt_pk_bf16(v0[0], v0[1]); w.y = cvt_pk_bf16(v0[2], v0[3]); w.z = cvt_pk_bf16(v1[0], v1[1]); w.w = cvt_pk_bf16(v1[2], v1[3]);
                    *(u32x4*)(rowp + bj * HALF) = w; } }
    }
};
struct EpiSqRelu {
    static constexpr bool PERM = true, AFTER_DRAIN = false;
    bf16_t* O; int ldc; const float* bias;
    __device__ __forceinline__ void operator()(const f32x4 (&acc)[2][2][4][2], const Unit& u, int wr, int wc, int fr, int fq) const {
        const int row0 = u.pm * BM + wr * 64 + fr, col0 = u.pn * BM + wc * 32 + 8 * fq;
        f32x4 bv[2][2];
#pragma unroll
        for (int bj = 0; bj < 2; ++bj)
#pragma unroll
            for (int n = 0; n < 2; ++n) bv[bj][n] = *(const f32x4*)(bias + col0 + bj * HALF + 4 * n);
#pragma unroll
        for (int ai = 0; ai < 2; ++ai)
#pragma unroll
            for (int m = 0; m < 4; ++m) { bf16_t* rowp = O + (size_t)(row0 + ai * HALF + m * 16) * ldc + col0;
#pragma unroll
                for (int bj = 0; bj < 2; ++bj) { f32x4 v0 = acc[ai][bj][m][0] + bv[bj][0], v1 = acc[ai][bj][m][1] + bv[bj][1];
#pragma unroll
                    for (int e = 0; e < 4; ++e) { const float a = fmaxf(v0[e], 0.f), b = fmaxf(v1[e], 0.f); v0[e] = a * a; v1[e] = b * b; }
                    u32x4 w; w.x = cvt_pk_bf16(v0[0], v0[1]); w.y = cvt_pk_bf16(v0[2], v0[3]); w.z = cvt_pk_bf16(v1[0], v1[1]); w.w = cvt_pk_bf16(v1[2], v1[3]);
                    *(u32x4*)(rowp + bj * HALF) = w; } }
    }
};
template <bool SECOND> struct EpiMerge {
    static constexpr bool PERM = true, AFTER_DRAIN = false;
    const bf16_t* gates; int goff; float* part; bf16_t* merged;
    __device__ __forceinline__ void operator()(const f32x4 (&acc)[2][2][4][2], const Unit& u, int wr, int wc, int fr, int fq) const {
        const int row0 = u.pm * BM + wr * 64 + fr, col0 = u.pn * BM + wc * 32 + 8 * fq;
#pragma unroll
        for (int ai = 0; ai < 2; ++ai)
#pragma unroll
            for (int m = 0; m < 4; ++m) { const size_t row = (size_t)(row0 + ai * HALF + m * 16);
#pragma unroll
                for (int bj = 0; bj < 2; ++bj) { const int col = col0 + bj * HALF;
                    const u32x4 gw = *(const u32x4*)(gates + row * 2048 + goff + col);
                    f32x4 g0, g1; g0[0] = __builtin_bit_cast(float, gw.x << 16); g0[1] = __builtin_bit_cast(float, gw.x & 0xffff0000u); g0[2] = __builtin_bit_cast(float, gw.y << 16); g0[3] = __builtin_bit_cast(float, gw.y & 0xffff0000u);
                    g1[0] = __builtin_bit_cast(float, gw.z << 16); g1[1] = __builtin_bit_cast(float, gw.z & 0xffff0000u); g1[2] = __builtin_bit_cast(float, gw.w << 16); g1[3] = __builtin_bit_cast(float, gw.w & 0xffff0000u);
                    f32x4 v0 = acc[ai][bj][m][0] * g0, v1 = acc[ai][bj][m][1] * g1; float* pp = part + row * 1024 + col;
                    if (!SECOND) { *(f32x4*)pp = v0; *(f32x4*)(pp + 4) = v1; }
                    else { v0 = v0 + *(const f32x4*)pp; v1 = v1 + *(const f32x4*)(pp + 4);
                        u32x4 w; w.x = cvt_pk_bf16(v0[0], v0[1]); w.y = cvt_pk_bf16(v0[2], v0[3]); w.z = cvt_pk_bf16(v1[0], v1[1]); w.w = cvt_pk_bf16(v1[2], v1[3]);
                        *(u32x4*)(merged + row * 1024 + col) = w; } }
                asm volatile("" ::: "memory"); }
    }
};
struct EpiResF32 {
    static constexpr bool PERM = true, AFTER_DRAIN = false;
    const float* base; float* out; const float* bias; float alpha;
    __device__ __forceinline__ void operator()(const f32x4 (&acc)[2][2][4][2], const Unit& u, int wr, int wc, int fr, int fq) const {
        const int row0 = u.pm * BM + wr * 64 + fr, col0 = u.pn * BM + wc * 32 + 8 * fq;
        f32x4 bv[2][2];
#pragma unroll
        for (int bj = 0; bj < 2; ++bj)
#pragma unroll
            for (int n = 0; n < 2; ++n) bv[bj][n] = bias ? *(const f32x4*)(bias + col0 + bj * HALF + 4 * n) : (f32x4){0.f, 0.f, 0.f, 0.f};
#pragma unroll
        for (int ai = 0; ai < 2; ++ai)
#pragma unroll
            for (int m = 0; m < 4; ++m) { const size_t off = (size_t)(row0 + ai * HALF + m * 16) * 1024 + col0;
#pragma unroll
                for (int bj = 0; bj < 2; ++bj) { const f32x4 b0 = *(const f32x4*)(base + off + bj * HALF), b1 = *(const f32x4*)(base + off + bj * HALF + 4);
                    *(f32x4*)(out + off + bj * HALF) = b0 * alpha + acc[ai][bj][m][0] + bv[bj][0]; *(f32x4*)(out + off + bj * HALF + 4) = b1 * alpha + acc[ai][bj][m][1] + bv[bj][1]; }
                asm volatile("" ::: "memory"); }
    }
};
template <class Epi, class Sched, bool ALIGN_EPI = false, bool SP2 = false>
__device__ __forceinline__ void gemm_phase(PG8_LAS unsigned char* lds, const Gemm g, const Sched& S, const Epi& E) {
    int tid_ = threadIdx.x; asm volatile("" : "+v"(tid_));
    const int tid = tid_, wid = __builtin_amdgcn_readfirstlane(tid >> 6), lane = tid & 63, wr = wid >> 2, wc = wid & 3, fr = lane & 15, fq = lane >> 4;
    const int K = g.K, nt = K / BK;
    unsigned voffA[2], voffB[2];
#pragma unroll
    for (int i = 0; i < 2; ++i) { int R, C; stage_rc(tid * 16 + i * 8192, R, C); const int Rb = Epi::PERM ? ((R & ~31) + perm32(R & 31)) : R;
        voffA[i] = (unsigned)(R * K + C) * 2u; voffB[i] = (unsigned)(Rb * K + C) * 2u; }
    const size_t kstep = (size_t)(BK * 2);
    const size_t hstep = (size_t)HALF * K * 2;
    const size_t tstep = 2 * hstep;
    const unsigned ldsw = (unsigned)wid * 1024u;
    const int aoff = lds_byte(wr * 64 + fr, fq * 8), boff = lds_byte(wc * 32 + fr, fq * 8);
#define PG8_SA(b, h) (((b) * 2 + (h)) * HTB)
#define PG8_SB(b, h) ((4 + (b) * 2 + (h)) * HTB)
#define PG8_STAGE(bufoff, gbase, voff) do { _Pragma("unroll") for (int _i = 0; _i < 2; ++_i) \
        __builtin_amdgcn_global_load_lds((const unsigned*)((const char*)(gbase) + (voff)[_i]), (PG8_LAS unsigned*)(lds + (bufoff) + ldsw + _i * 8192), 16, 0, 0); } while (0)
#define PG8_LDA(dst, b, h) do { _Pragma("unroll") for (int m = 0; m < 4; ++m) _Pragma("unroll") for (int k = 0; k < 2; ++k) dst[m][k] = *(const PG8_LAS bf16x8*)(lds + PG8_SA(b, h) + aoff + m * 2048 + k * 1024); } while (0)
#define PG8_LDB(dst, b, h) do { _Pragma("unroll") for (int n = 0; n < 2; ++n) _Pragma("unroll") for (int k = 0; k < 2; ++k) dst[n][k] = *(const PG8_LAS bf16x8*)(lds + PG8_SB(b, h) + boff + n * 2048 + k * 1024); } while (0)
#define PG8_MMA(ai, bj, At, Bt) do { __builtin_amdgcn_s_setprio(1); _Pragma("unroll") for (int m = 0; m < 4; ++m) _Pragma("unroll") for (int n = 0; n < 2; ++n) _Pragma("unroll") for (int k = 0; k < 2; ++k) \
        acc[ai][bj][m][n] = __builtin_amdgcn_mfma_f32_16x16x32_bf16(Bt[n][k], At[m][k], acc[ai][bj][m][n], 0, 0, 0); __builtin_amdgcn_s_setprio(0); } while (0)
#define PG8_WAIT_V(n) asm volatile("s_waitcnt vmcnt(" #n ")" ::: "memory")
#define PG8_WAIT_L(n) asm volatile("s_waitcnt lgkmcnt(" #n ")" ::: "memory")
#define PG8_BAR __builtin_amdgcn_s_barrier()
#define PG8_SCHED __builtin_amdgcn_sched_barrier(0)
    Unit cur, nxt; int ui = 0;
    if (!S.next(0, cur)) return;
    f32x4 acc[2][2][4][2];
#pragma unroll
    for (int a = 0; a < 2; ++a)
#pragma unroll
        for (int b = 0; b < 2; ++b)
#pragma unroll
            for (int m = 0; m < 4; ++m)
#pragma unroll
                for (int n = 0; n < 2; ++n) acc[a][b][m][n] = (f32x4){0.f, 0.f, 0.f, 0.f};
    bf16x8 At[4][2], B0[2][2], B1[2][2];
    const char* cA = (const char*)g.A + (size_t)cur.pm * tstep; const char* cB = (const char*)g.Bt + (size_t)cur.pn * tstep;
    S.a_ready(cur);
    if constexpr (SP2) {
        PG8_STAGE(PG8_SB(0, 0), cB, voffB); PG8_STAGE(PG8_SB(0, 1), cB + hstep, voffB); PG8_STAGE(PG8_SA(0, 0), cA, voffA); PG8_STAGE(PG8_SA(0, 1), cA + hstep, voffA);
        if (wr == 1) PG8_BAR;
        PG8_WAIT_V(2); PG8_BAR;
        PG8_STAGE(PG8_SB(1, 0), cB + kstep, voffB); PG8_STAGE(PG8_SA(1, 0), cA + kstep, voffA); PG8_STAGE(PG8_SB(1, 1), cB + hstep + kstep, voffB);
        PG8_WAIT_V(6); PG8_BAR;
    } else {
        PG8_STAGE(PG8_SB(0, 0), cB, voffB); PG8_STAGE(PG8_SA(0, 0), cA, voffA); PG8_STAGE(PG8_SB(0, 1), cB + hstep, voffB); PG8_STAGE(PG8_SA(0, 1), cA + hstep, voffA);
        if (wr == 1) PG8_BAR;
        PG8_WAIT_V(4); PG8_BAR;
        PG8_STAGE(PG8_SB(1, 0), cB + kstep, voffB); PG8_STAGE(PG8_SA(1, 0), cA + kstep, voffA); PG8_STAGE(PG8_SB(1, 1), cB + hstep + kstep, voffB);
        PG8_WAIT_V(6); PG8_BAR;
    }
    for (;;) {
        const bool has_next = S.next(ui + 1, nxt);
        const char* nA = has_next ? (const char*)g.A + (size_t)nxt.pm * tstep : cA; const char* nB = has_next ? (const char*)g.Bt + (size_t)nxt.pn * tstep : cB;
        for (int t = 0; t < nt; t += 2) {
            const bool last = (t == nt - 2);
            const char* a1 = cA + (size_t)(t + 1) * kstep;
            const char* a2 = last ? nA : cA + (size_t)(t + 2) * kstep; const char* b2 = last ? nB : cB + (size_t)(t + 2) * kstep;
            const char* a3 = a2 + kstep; const char* b3 = b2 + kstep;
            if (last && has_next) S.a_ready(nxt);
            if constexpr (SP2) {
            PG8_LDB(B0, 0, 0); PG8_LDB(B1, 0, 1); PG8_SCHED; PG8_LDA(At, 0, 0); PG8_STAGE(PG8_SA(1, 1), a1 + hstep, voffA);
            PG8_WAIT_V(8); PG8_WAIT_L(0); PG8_BAR; PG8_MMA(0, 0, At, B0); PG8_MMA(0, 1, At, B1); PG8_BAR; PG8_SCHED;
            PG8_LDA(At, 0, 1); PG8_STAGE(PG8_SB(0, 0), b2, voffB); PG8_STAGE(PG8_SB(0, 1), b2 + hstep, voffB); PG8_STAGE(PG8_SA(0, 0), a2, voffA);
            PG8_WAIT_V(8); PG8_WAIT_L(0); PG8_BAR; PG8_MMA(1, 0, At, B0); PG8_MMA(1, 1, At, B1); PG8_BAR; PG8_SCHED;
            PG8_LDB(B0, 1, 0); PG8_LDB(B1, 1, 1); PG8_SCHED; PG8_LDA(At, 1, 0); PG8_STAGE(PG8_SA(0, 1), a2 + hstep, voffA);
            PG8_WAIT_V(8); PG8_WAIT_L(0); PG8_BAR; PG8_MMA(0, 0, At, B0); PG8_MMA(0, 1, At, B1); PG8_BAR; PG8_SCHED;
            PG8_LDA(At, 1, 1); PG8_STAGE(PG8_SB(1, 0), b3, voffB); PG8_STAGE(PG8_SB(1, 1), b3 + hstep, voffB); PG8_STAGE(PG8_SA(1, 0), a3, voffA);
            PG8_WAIT_V(8); PG8_WAIT_L(0); PG8_BAR; PG8_MMA(1, 0, At, B0); PG8_MMA(1, 1, At, B1); PG8_BAR; PG8_SCHED;
            } else {
            PG8_LDB(B0, 0, 0); PG8_SCHED; PG8_LDA(At, 0, 0); PG8_STAGE(PG8_SA(1, 1), a1 + hstep, voffA);
            PG8_WAIT_L(8); PG8_BAR; PG8_WAIT_L(0); PG8_MMA(0, 0, At, B0); PG8_BAR; PG8_SCHED;
            PG8_LDB(B1, 0, 1); PG8_STAGE(PG8_SB(0, 0), b2, voffB);
            PG8_BAR; PG8_WAIT_L(0); PG8_MMA(0, 1, At, B1); PG8_BAR;
            PG8_LDA(At, 0, 1); PG8_STAGE(PG8_SA(0, 0), a2, voffA);
            PG8_BAR; PG8_WAIT_L(0); PG8_MMA(1, 0, At, B0); PG8_BAR; PG8_SCHED;
            PG8_STAGE(PG8_SB(0, 1), b2 + hstep, voffB);
            PG8_WAIT_V(6); PG8_BAR; PG8_MMA(1, 1, At, B1); PG8_BAR;
            PG8_LDB(B0, 1, 0); PG8_SCHED; PG8_LDA(At, 1, 0); PG8_STAGE(PG8_SA(0, 1), a2 + hstep, voffA);
            PG8_WAIT_L(8); PG8_BAR; PG8_WAIT_L(0); PG8_MMA(0, 0, At, B0); PG8_BAR; PG8_SCHED;
            PG8_LDB(B1, 1, 1); PG8_STAGE(PG8_SB(1, 0), b3, voffB);
            PG8_BAR; PG8_WAIT_L(0); PG8_MMA(0, 1, At, B1); PG8_BAR;
            PG8_LDA(At, 1, 1); PG8_STAGE(PG8_SA(1, 0), a3, voffA);
            PG8_BAR; PG8_WAIT_L(0); PG8_MMA(1, 0, At, B0); PG8_BAR; PG8_SCHED;
            PG8_STAGE(PG8_SB(1, 1), b3 + hstep, voffB);
            PG8_WAIT_V(6); PG8_BAR; PG8_MMA(1, 1, At, B1); PG8_BAR;
            }
        }
        if constexpr (ALIGN_EPI) { if (wr == 0) PG8_BAR; }
        if constexpr (!Epi::AFTER_DRAIN) { E(acc, cur, wr, wc, fr, fq); S.done(cur); }
        if (!has_next) break;
#pragma unroll
        for (int a = 0; a < 2; ++a)
#pragma unroll
            for (int b = 0; b < 2; ++b)
#pragma unroll
                for (int m = 0; m < 4; ++m)
#pragma unroll
                    for (int n = 0; n < 2; ++n) acc[a][b][m][n] = (f32x4){0.f, 0.f, 0.f, 0.f};
        cur = nxt; cA = nA; cB = nB; ++ui;
        if constexpr (ALIGN_EPI) { if (wr == 1) PG8_BAR; }
    }
    PG8_WAIT_V(0);
    if constexpr (!ALIGN_EPI) { if (wr == 0) PG8_BAR; }
    PG8_BAR;
    if constexpr (Epi::AFTER_DRAIN) { E.fused(acc, cur, wr, wc, fr, fq, lds, wid, lane); S.done(cur); }
#undef PG8_SA
#undef PG8_SB
#undef PG8_STAGE
#undef PG8_LDA
#undef PG8_LDB
#undef PG8_MMA
#undef PG8_WAIT_V
#undef PG8_WAIT_L
#undef PG8_BAR
#undef PG8_SCHED
}
}
#define PG8_SP2 true
#define PG8_ALIGN true
#define GAS __attribute__((address_space(1)))
#define LAS __attribute__((address_space(3)))
typedef unsigned short bf16;
typedef unsigned v4u __attribute__((ext_vector_type(4)));
typedef float f32x4 __attribute__((ext_vector_type(4)));
typedef short bf16x8 __attribute__((ext_vector_type(8)));
typedef GAS unsigned gu32;
typedef GAS unsigned long long gu64;
#define RLX_AGENT __ATOMIC_RELAXED, __HIP_MEMORY_SCOPE_AGENT
#define LDS_WAIT() asm volatile("s_waitcnt lgkmcnt(0)" ::: "memory")
#define VM_WAIT() asm volatile("s_waitcnt vmcnt(0)" ::: "memory")
__device__ __forceinline__ unsigned long long rt() { return __builtin_amdgcn_s_memrealtime(); }
__device__ __forceinline__ unsigned f2bf(float f) { unsigned u = __builtin_bit_cast(unsigned, f); return (u + 0x7fffu + ((u >> 16) & 1u)) >> 16; }
__device__ __forceinline__ unsigned pk2(float lo, float hi) { return f2bf(lo) | (f2bf(hi) << 16); }

#define XB_TMO      128
#define XB_XCNT(j)  (256  + 64 * (j))
#define XB_XSUB(j)  (1280 + 64 * (j))
#define XB_XGEN(j)  (2304 + 64 * (j))
#define XB_TOP      3328
#define XB_TOPGEN   3392
#define XCD_BAR_WORDS 3456
#define XB_SPIN_CAP (1u << 18)

__device__ __forceinline__ unsigned xb_ld(unsigned* p)              { return __hip_atomic_load(p, __ATOMIC_RELAXED, __HIP_MEMORY_SCOPE_AGENT); }
__device__ __forceinline__ unsigned xb_add(unsigned* p, unsigned v) { return __hip_atomic_fetch_add(p, v, __ATOMIC_RELAXED, __HIP_MEMORY_SCOPE_AGENT); }
__device__ __forceinline__ unsigned xb_xcc_id() { return (unsigned)__builtin_amdgcn_s_getreg((3 << 11) | 20) & 0xFu; }
#define XB_SPIN(cond, bar) do { unsigned _sp = 0; while (cond) { __builtin_amdgcn_s_sleep(1); \
    if ((++_sp & 255u) == 0u) { if (xb_ld(&(bar)[XB_TMO])) break; if (_sp > XB_SPIN_CAP) { atomicAdd(&(bar)[XB_TMO], 1u); break; } } } } while (0)

struct XcdBarrier {
    unsigned* bar; unsigned x;
    volatile LAS unsigned* st;
};

__device__ __forceinline__ XcdBarrier xcd_barrier_post(unsigned* bar, volatile LAS unsigned* st) {
    XcdBarrier b; b.bar = bar; b.x = xb_xcc_id(); b.st = st;
    if (threadIdx.x == 0) (void)xb_add(&bar[XB_XCNT(b.x)], 1u);
    return b;
}
__device__ __forceinline__ void xcd_barrier_complete(unsigned* bar, unsigned x, unsigned& nloc, unsigned& nx) {
    const unsigned G = gridDim.x * gridDim.y * gridDim.z;
    unsigned sum, cnt, mine, sp = 0u;
    for (;;) {
        sum = 0u; cnt = 0u; mine = 0u;
#pragma unroll
        for (unsigned j = 0; j < 16; ++j) { const unsigned c = xb_ld(&bar[XB_XCNT(j)]); sum += c; cnt += (c > 0u) ? 1u : 0u; mine = (j == x) ? c : mine; }
        if (sum == G) break;
        __builtin_amdgcn_s_sleep(1);
        if ((++sp & 255u) == 0u) { if (xb_ld(&bar[XB_TMO])) break; if (sp > XB_SPIN_CAP) { atomicAdd(&bar[XB_TMO], 1u); break; } }
    }
    nloc = mine > 0u ? mine : 1u; nx = cnt > 0u ? cnt : 1u;
}

__device__ __forceinline__ void xcd_barrier(const XcdBarrier& b) {
    asm volatile("s_waitcnt vmcnt(0)" ::: "memory");
    __syncthreads();
    if (threadIdx.x == 0) {
        unsigned* bar = b.bar;
        __builtin_amdgcn_s_waitcnt(0);
        unsigned nloc = b.st[0], nx = b.st[1];
        if (nloc == 0u) { xcd_barrier_complete(bar, b.x, nloc, nx); b.st[0] = nloc; b.st[1] = nx; }
        const unsigned old = xb_add(&bar[XB_XSUB(b.x)], 1u);
        const unsigned gen = old / nloc;
        if (old + 1u == (gen + 1u) * nloc) {
            __builtin_amdgcn_fence(__ATOMIC_RELEASE, "agent");
            asm volatile("s_waitcnt vmcnt(0)" ::: "memory");
            const unsigned og = xb_add(&bar[XB_TOP], 1u);
            const unsigned tg = og / nx;
            if (og + 1u == (tg + 1u) * nx) xb_add(&bar[XB_TOPGEN], 1u);
            else XB_SPIN(xb_ld(&bar[XB_TOPGEN]) == tg, bar);
            __builtin_amdgcn_fence(__ATOMIC_ACQUIRE, "agent");
            xb_add(&bar[XB_XGEN(b.x)], 1u);
            asm volatile("s_waitcnt vmcnt(0)" ::: "memory");
        } else {
            XB_SPIN(xb_ld(&bar[XB_XGEN(b.x)]) == gen, bar);
            __builtin_amdgcn_fence(__ATOMIC_ACQUIRE, "agent");
            asm volatile("s_waitcnt vmcnt(0)" ::: "memory");
        }
    }
    __syncthreads();
}

constexpr int NWAVES = 8;
constexpr int BATCH = 8, SEQ = 2048, D = 1024, M = BATCH * SEQ, FF = 4096;
constexpr int IN_COLS = 5920, NPROJ = 6144, QKVW = 2304;
constexpr float ALPHA = 1.18920711500272106672f;
constexpr float LN_EPS = 1e-5f, NORM_EPS = 1e-6f;
constexpr int NPH = 11;
#ifndef MK_PER_PHASE
#define MK_PER_PHASE 0
#endif

constexpr size_t MiB = 1u << 20;
constexpr size_t WS_CTL = 0, CTL_ZERO_BYTES = 1 * MiB;
constexpr size_t WS_WOUT = 1 * MiB, WS_WAB = 3 * MiB, WS_WGB = 4 * MiB, WS_WFF1 = 5 * MiB, WS_WFF2 = 13 * MiB, WS_WIN = 21 * MiB;
constexpr size_t WS_YATTN = 21 * MiB, WS_DEC = 29 * MiB, WS_LSE = 30 * MiB;
constexpr size_t WS_XB = 33 * MiB;
constexpr size_t WS_STATES = 33 * MiB;
constexpr size_t WS_X1B = 33 * MiB;
constexpr size_t WS_QKV = 65 * MiB;
constexpr size_t WS_GQK = 137 * MiB, WS_GV = 153 * MiB, WS_GOUT = 169 * MiB;
constexpr size_t WS_LR = 185 * MiB;
constexpr size_t WS_GATES = 187 * MiB;
constexpr size_t WS_PART = 65 * MiB;
constexpr size_t WS_MERGED = 129 * MiB;
constexpr size_t WS_H = 65 * MiB;
constexpr size_t WS_END = 251 * MiB;
constexpr int CW_TMO = 0, CW_CODE = 1, CW_BAR = 4096;

constexpr int RING_OFF = 0, RING_BYTES = 131072;
constexpr int LDSCTL_OFF = RING_BYTES, MISC_OFF = LDSCTL_OFF + 320;
constexpr int LDS_BYTES = 147456;

__device__ const unsigned char T5B[3][132] = {
 {11,11,11,11,11,11,11,11,11,11,11,11,11,11,11,10,10,10,10,10,10,10,10,10,10,10,10,10,10,10,10,10,10,10,10,10,10,10,9,9,9,9,9,9,9,9,9,9,9,9,8,8,8,8,8,8,8,7,6,5,4,3,2,1,0,17,18,19,20,21,22,23,24,24,24,24,24,24,24,25,25,25,25,25,25,25,25,25,25,25,25,26,26,26,26,26,26,26,26,26,26,26,26,26,26,26,26,26,26,26,26,26,26,26,27,27,27,27,27,27,27,27,27,27,27,27,27,27,27,0,0,0},
 {13,13,13,13,13,13,13,13,13,13,13,13,13,13,13,13,13,13,13,13,13,13,13,12,12,12,12,12,12,12,12,12,12,12,12,12,12,12,12,12,12,12,11,11,11,11,11,11,11,11,11,11,10,10,10,10,10,10,9,9,9,8,8,4,0,20,24,24,25,25,25,26,26,26,26,26,26,27,27,27,27,27,27,27,27,27,27,28,28,28,28,28,28,28,28,28,28,28,28,28,28,28,28,28,28,28,29,29,29,29,29,29,29,29,29,29,29,29,29,29,29,29,29,29,29,29,29,29,29,0,0,0},
 {15,15,15,15,15,15,15,15,15,15,15,15,15,15,15,15,15,15,15,15,15,15,15,15,15,15,15,15,15,15,14,14,14,14,14,14,14,14,14,14,14,14,14,14,14,13,13,13,13,13,13,13,13,13,12,12,12,12,12,11,11,10,10,9,0,25,26,26,27,27,28,28,28,28,28,29,29,29,29,29,29,29,29,29,30,30,30,30,30,30,30,30,30,30,30,30,30,30,30,31,31,31,31,31,31,31,31,31,31,31,31,31,31,31,31,31,31,31,31,31,31,31,31,31,31,31,31,31,31,0,0,0}};

struct Frame {
    LAS unsigned char* lds;
    volatile LAS unsigned* MISC;
    gu32* ctl;
    int tid, lane, wave;
    int vcu, G;
    const float* x; float* out;
    const float *w_in, *rel_bias, *w_lr_f, *b_lr_f, *w_lr_b, *b_lr_b, *gla_g, *w_ab, *w_gb, *w_out, *ln1_g, *ln1_b, *w_ff1, *b_ff1, *w_ff2, *b_ff2, *ln2_g, *ln2_b;
    bf16 *WIN_t, *WAB_t, *WGB_t, *WOUT_t, *WFF1_t, *WFF2_t;
    bf16 *XB, *QKV, *GQK, *GV, *GOUT, *GATES, *YATTN, *STATES, *MERGED, *X1B, *HB;
    float *LR, *DEC, *PART, *LSE;
};
__device__ __forceinline__ float bf2f(bf16 h) { return __builtin_bit_cast(float, (unsigned)h << 16); }
__device__ __forceinline__ float wave_sum(float v) {
#pragma unroll
    for (int o = 1; o < 64; o <<= 1) v += __shfl_xor(v, o);
    return v;
}
__device__ __forceinline__ float wave_max(float v) {
#pragma unroll
    for (int o = 1; o < 64; o <<= 1) v = fmaxf(v, __shfl_xor(v, o));
    return v;
}
__device__ __forceinline__ float rdlane(float v, int l) { return __builtin_bit_cast(float, __builtin_amdgcn_readlane(__builtin_bit_cast(int, v), l)); }

template <bool REMAP>
__device__ __forceinline__ void p0_transpose_item(const float* W, int K, int N, bf16* WT, LAS float* scr, int item, int lane) {
    const int nblk = N / 32, kb = item / nblk, nb = item % nblk, k0 = 64 * kb, n0 = 32 * nb;
    const int row_off = (REMAP && n0 >= 3872) ? 224 : 0;
#pragma unroll 8
    for (int i = 0; i < 32; ++i) { const int kk = 2 * i + (lane >> 5); scr[kk * 33 + (lane & 31)] = W[(size_t)(k0 + kk) * N + n0 + (lane & 31)]; }
    LDS_WAIT(); asm volatile("" ::: "memory");
    const int c = lane & 7;
#pragma unroll
    for (int j = 0; j < 4; ++j) { const int n = (lane >> 3) + 8 * j; const LAS float* s = scr + (8 * c) * 33 + n;
        v4u o; o.x = pk2(s[0 * 33], s[1 * 33]); o.y = pk2(s[2 * 33], s[3 * 33]); o.z = pk2(s[4 * 33], s[5 * 33]); o.w = pk2(s[6 * 33], s[7 * 33]);
        *(GAS v4u*)(WT + (size_t)(row_off + n0 + n) * K + k0 + 8 * c) = o; }
    LDS_WAIT(); asm volatile("" ::: "memory");
}
__device__ __forceinline__ void p0_prologue(Frame& F) {
    LAS float* scr = (LAS float*)(F.lds + RING_OFF + F.wave * 16384);
    const int gw = F.vcu * NWAVES + F.wave, NGW = F.G * NWAVES;
    constexpr int I_IN = (D / 64) * (IN_COLS / 32), I_AB = (256 / 64) * (D / 32), I_GB = (512 / 64) * (D / 32), I_OUT = (D / 64) * (D / 32), I_1 = (D / 64) * (FF / 32), I_2 = (FF / 64) * (D / 32);
    constexpr int NITEMS = I_IN + I_AB + I_GB + I_OUT + I_1 + I_2;
    for (int it = gw; it < NITEMS; it += NGW) {
        int r = it;
        if (r < I_IN) { p0_transpose_item<true>(F.w_in, D, IN_COLS, F.WIN_t, scr, r, F.lane); continue; } r -= I_IN;
        if (r < I_AB) { p0_transpose_item<false>(F.w_ab, 256, D, F.WAB_t, scr, r, F.lane); continue; } r -= I_AB;
        if (r < I_GB) { p0_transpose_item<false>(F.w_gb, 512, D, F.WGB_t, scr, r, F.lane); continue; } r -= I_GB;
        if (r < I_OUT) { p0_transpose_item<false>(F.w_out, D, D, F.WOUT_t, scr, r, F.lane); continue; } r -= I_OUT;
        if (r < I_1) { p0_transpose_item<false>(F.w_ff1, D, FF, F.WFF1_t, scr, r, F.lane); continue; } r -= I_1;
        p0_transpose_item<false>(F.w_ff2, FF, D, F.WFF2_t, scr, r, F.lane);
    }
    for (int rr = gw; rr < 224; rr += NGW) { GAS v4u* o = (GAS v4u*)(F.WIN_t + (size_t)(3872 + rr) * D) + F.lane; o[0] = (v4u){0u, 0u, 0u, 0u}; o[64] = (v4u){0u, 0u, 0u, 0u}; }
    for (int m = gw; m < M; m += NGW) {
        const GAS f32x4* xr = (const GAS f32x4*)(F.x + (size_t)m * D) + F.lane;
        GAS unsigned long long* o8 = (GAS unsigned long long*)(F.XB + (size_t)m * D) + F.lane;
#pragma unroll
        for (int j = 0; j < 4; ++j) { const f32x4 v = xr[64 * j]; o8[64 * j] = (unsigned long long)pk2(v.x, v.y) | ((unsigned long long)pk2(v.z, v.w) << 32); }
    }
}

__device__ __forceinline__ void ln_rows(Frame& F, float* buf, const float* g, const float* b, bf16* ob) {
    const int gw = F.vcu * NWAVES + F.wave, NGW = F.G * NWAVES;
    for (int m = gw; m < M; m += NGW) {
        GAS f32x4* xr = (GAS f32x4*)(buf + (size_t)m * D) + F.lane;
        f32x4 v[4]; float s = 0.f;
#pragma unroll
        for (int j = 0; j < 4; ++j) { v[j] = xr[64 * j]; s += (v[j].x + v[j].y) + (v[j].z + v[j].w); }
        const float mean = wave_sum(s) * (1.f / D); float s2 = 0.f;
#pragma unroll
        for (int j = 0; j < 4; ++j) { v[j] = v[j] - mean; s2 += (v[j].x * v[j].x + v[j].y * v[j].y) + (v[j].z * v[j].z + v[j].w * v[j].w); }
        const float rstd = 1.f / sqrtf(wave_sum(s2) * (1.f / D) + LN_EPS);
#pragma unroll
        for (int j = 0; j < 4; ++j) { const f32x4 gg = *((const GAS f32x4*)g + F.lane + 64 * j), bb = *((const GAS f32x4*)b + F.lane + 64 * j);
            const f32x4 o = v[j] * rstd * gg + bb; xr[64 * j] = o;
            if (ob) ((GAS unsigned long long*)(ob + (size_t)m * D) + F.lane)[64 * j] = (unsigned long long)pk2(o.x, o.y) | ((unsigned long long)pk2(o.z, o.w) << 32); }
    }
}

__device__ __forceinline__ void attn_simple(Frame& F) {
    const int gw = F.vcu * NWAVES + F.wave, NGW = F.G * NWAVES, lane = F.lane;
    for (int task = gw; task < M * 4; task += NGW) {
        const int tok = task >> 2, j = task & 3, b = tok / SEQ, t = tok % SEQ;
        float mrun = -INFINITY, lrun = 0.f, orun = 0.f;
#pragma unroll 1
        for (int g = 0; g < 3; ++g) {
            const int r = (g == 0) ? 1 : (g == 1) ? 4 : 16, head = g * 4 + j;
            const bf16* Kb = F.QKV + (size_t)b * SEQ * QKVW + 768 + head * 64;
            const bf16* Vb = F.QKV + (size_t)b * SEQ * QKVW + 1536 + head * 64;
            const float qd = bf2f(F.QKV[(size_t)tok * QKVW + head * 64 + lane]);
            const int pA = t + r * (lane - 64), pB = t + r * lane, pC = t + r * 64;
            const bool vA = pA >= 0, vB = pB < SEQ, vC = pC < SEQ;
            float sA = 0.f, sB = 0.f;
            {
                const v4u* ka = (const v4u*)(Kb + (size_t)(vA ? pA : t) * QKVW);
                const v4u* kb = (const v4u*)(Kb + (size_t)(vB ? pB : t) * QKVW);
#pragma unroll
                for (int d8 = 0; d8 < 8; ++d8) { const v4u a = ka[d8], bq = kb[d8];
                    const unsigned aw[4] = {a.x, a.y, a.z, a.w}, bw[4] = {bq.x, bq.y, bq.z, bq.w};
#pragma unroll
                    for (int e = 0; e < 4; ++e) { const float q0 = rdlane(qd, d8 * 8 + 2 * e), q1 = rdlane(qd, d8 * 8 + 2 * e + 1);
                        sA += q0 * __builtin_bit_cast(float, aw[e] << 16) + q1 * __builtin_bit_cast(float, aw[e] & 0xffff0000u);
                        sB += q0 * __builtin_bit_cast(float, bw[e] << 16) + q1 * __builtin_bit_cast(float, bw[e] & 0xffff0000u); } }
            }
            float sC = wave_sum(qd * bf2f(Kb[(size_t)(vC ? pC : t) * QKVW + lane]));
            sA += F.rel_bias[T5B[g][lane] * 12 + head]; sB += F.rel_bias[T5B[g][lane + 64] * 12 + head]; sC += F.rel_bias[T5B[g][128] * 12 + head];
            if (!vA) sA = -1e30f; if (!vB) sB = -1e30f; if (!vC) sC = -1e30f;
            const float mg = fmaxf(wave_max(fmaxf(sA, sB)), sC);
            const float mnew = fmaxf(mrun, mg), sc = __expf(mrun - mnew);
            const float pa = vA ? __expf(sA - mnew) : 0.f, pb = vB ? __expf(sB - mnew) : 0.f, pc = vC ? __expf(sC - mnew) : 0.f;
            lrun = lrun * sc + wave_sum(pa + pb) + pc; orun *= sc; mrun = mnew;
#pragma unroll 8
            for (int kk = 0; kk < 64; ++kk) { const int pos = t + r * (kk - 64); if (pos >= 0) orun += rdlane(pa, kk) * bf2f(Vb[(size_t)pos * QKVW + lane]); }
#pragma unroll 8
            for (int kk = 0; kk < 64; ++kk) { const int pos = t + r * kk; if (pos < SEQ) orun += rdlane(pb, kk) * bf2f(Vb[(size_t)pos * QKVW + lane]); }
            if (vC) orun += pc * bf2f(Vb[(size_t)pC * QKVW + lane]);
        }
        F.YATTN[(size_t)tok * 256 + j * 64 + lane] = (bf16)f2bf(orun / lrun);
    }
}


typedef short v4i16_t __attribute__((ext_vector_type(4)));
__device__ __forceinline__ v4i16_t lds_tr16(LAS const unsigned char* p) { return __builtin_amdgcn_ds_read_tr16_b64_v4i16((LAS v4i16_t*)p); }
__device__ __forceinline__ unsigned cvtpk(float lo, float hi) { unsigned r; asm volatile("v_cvt_pk_bf16_f32 %0, %1, %2" : "=v"(r) : "v"(lo), "v"(hi)); return r; }
__device__ __forceinline__ void attn_mfma(Frame& F) {
    LAS unsigned char* Ks = F.lds;
    LAS unsigned char* Vs = F.lds + 32768;
    LAS float* bt = (LAS float*)(F.lds + 65536);
    const int tid = F.tid, lane = F.lane, w = F.wave, l15 = lane & 15, g4 = lane >> 4;
    for (int u = F.vcu; u < 1536; u += F.G) {
        const int g = u >> 9, rem = u & 511, b = rem >> 6, hh = (rem >> 4) & 3, idx = rem & 15;
        const int r = 1 << (2 * g), lognb = 4 - 2 * g, c = idx >> lognb, nb = idx & ((1 << lognb) - 1), L = SEQ >> (2 * g), head = g * 4 + hh;
        bf16* base = F.QKV + (size_t)b * SEQ * QKVW + head * 64;
        if (tid < 160) { const int rel = tid - 80; bt[tid] = (rel >= -64 && rel <= 64) ? F.rel_bias[T5B[g][rel + 64] * 12 + head] : -1e30f; }
        const int m0 = 128 * nb - 64;
#pragma unroll
        for (int i = 0; i < 4; ++i) {
            const int piece = w * 4 + i, row = piece * 8 + (lane >> 3);
            int m = m0 + row; m = m < 0 ? 0 : (m > L - 1 ? L - 1 : m);
            const int chunk = (lane & 7) ^ (lane >> 3);
            const bf16* src = base + (size_t)(m * r + c) * QKVW + chunk * 8;
            __builtin_amdgcn_global_load_lds((const unsigned*)(src + 768), (LAS unsigned*)(Ks + piece * 1024), 16, 0, 0);
            __builtin_amdgcn_global_load_lds((const unsigned*)(src + 1536), (LAS unsigned*)(Vs + piece * 1024), 16, 0, 0);
        }
        const int mq0 = 128 * nb + 16 * w;
        bf16* qrow = base + (size_t)((mq0 + l15) * r + c) * QKVW;
        bf16x8 qf[2];
        qf[0] = *(const bf16x8*)(qrow + g4 * 8); qf[1] = *(const bf16x8*)(qrow + 32 + g4 * 8);
        asm volatile("s_waitcnt vmcnt(0)" ::: "memory");
        __syncthreads();
        f32x4 s[9];
#pragma unroll
        for (int t = 0; t < 9; ++t) {
            const int row = 16 * w + 16 * t + l15;
            f32x4 acc = (f32x4){0.f, 0.f, 0.f, 0.f};
#pragma unroll
            for (int ks = 0; ks < 2; ++ks) {
                const bf16x8 kf = *(const LAS bf16x8*)(Ks + row * 128 + (((4 * ks + g4) ^ (lane & 7)) << 4));
                acc = __builtin_amdgcn_mfma_f32_16x16x32_bf16(kf, qf[ks], acc, 0, 0, 0);
            }
            s[t] = acc;
        }
        const int lo = (64 - mq0) > 0 ? (64 - mq0) : 0, hi = (L + 64 - mq0) < 144 ? (L + 64 - mq0) : 144;
        float mx = -INFINITY;
#pragma unroll
        for (int t = 0; t < 9; ++t)
#pragma unroll
            for (int i = 0; i < 4; ++i) { const int kk = 16 * t + 4 * g4 + i; float v = s[t][i] + bt[kk + 16 - l15]; v = (kk < lo || kk >= hi) ? -1e30f : v; s[t][i] = v; mx = fmaxf(mx, v); }
        mx = fmaxf(mx, __shfl_xor(mx, 16)); mx = fmaxf(mx, __shfl_xor(mx, 32));
        float lsum = 0.f;
#pragma unroll
        for (int t = 0; t < 9; ++t)
#pragma unroll
            for (int i = 0; i < 4; ++i) { const float p = __expf(s[t][i] - mx); s[t][i] = p; lsum += p; }
        lsum += __shfl_xor(lsum, 16); lsum += __shfl_xor(lsum, 32);
        f32x4 o[4];
#pragma unroll
        for (int dt = 0; dt < 4; ++dt) o[dt] = (f32x4){0.f, 0.f, 0.f, 0.f};
        const int vr = 4 * g4 + (l15 >> 2), vsw = (4 * (g4 & 1) + (l15 >> 2)), vch = (lane & 3) >> 1, vo8 = 8 * (lane & 1);
#pragma unroll
        for (int ks = 0; ks < 5; ++ks) {
            const int t0 = 2 * ks, t1 = (2 * ks + 1 < 9) ? 2 * ks + 1 : 8;
            v4u pw; pw.x = cvtpk(s[t0][0], s[t0][1]); pw.y = cvtpk(s[t0][2], s[t0][3]);
            if (2 * ks + 1 < 9) { pw.z = cvtpk(s[t1][0], s[t1][1]); pw.w = cvtpk(s[t1][2], s[t1][3]); } else { pw.z = 0u; pw.w = 0u; }
            const bf16x8 pf = __builtin_bit_cast(bf16x8, pw);
            const int ra = 16 * w + 16 * t0 + vr, rb = 16 * w + 16 * t1 + vr;
#pragma unroll
            for (int dt = 0; dt < 4; ++dt) {
                const int sw = ((2 * dt + vch) ^ vsw) << 4;
                const v4i16_t va = lds_tr16(Vs + ra * 128 + sw + vo8), vb = lds_tr16(Vs + rb * 128 + sw + vo8);
                const bf16x8 vf = (bf16x8){va[0], va[1], va[2], va[3], vb[0], vb[1], vb[2], vb[3]};
                o[dt] = __builtin_amdgcn_mfma_f32_16x16x32_bf16(vf, pf, o[dt], 0, 0, 0);
            }
        }
        const float inv = 1.0f / lsum;
#pragma unroll
        for (int dt = 0; dt < 4; ++dt) { const unsigned long long wv = (unsigned long long)cvtpk(o[dt][0] * inv, o[dt][1] * inv) | ((unsigned long long)cvtpk(o[dt][2] * inv, o[dt][3] * inv) << 32);
            *(unsigned long long*)(qrow + 16 * dt + 4 * g4) = wv; }
        if (g4 == 0) F.LSE[((size_t)g * M + (size_t)b * SEQ + (size_t)((mq0 + l15) * r + c)) * 4 + hh] = mx + __logf(lsum);
        __syncthreads();
    }
}
__device__ __forceinline__ void attn_combine(Frame& F) {
    const int gw = F.vcu * NWAVES + F.wave, NGW = F.G * NWAVES, lane = F.lane, hh = lane >> 4, d4 = (lane & 15) * 4;
    for (int tok = gw; tok < M; tok += NGW) {
        float ls[3], mxl = -INFINITY;
#pragma unroll
        for (int g = 0; g < 3; ++g) { ls[g] = F.LSE[((size_t)g * M + tok) * 4 + hh]; mxl = fmaxf(mxl, ls[g]); }
        float wsum = 0.f, y0 = 0.f, y1 = 0.f, y2 = 0.f, y3 = 0.f;
#pragma unroll
        for (int g = 0; g < 3; ++g) { const float wg = __expf(ls[g] - mxl); wsum += wg;
            const unsigned long long v = *(const unsigned long long*)(F.QKV + (size_t)tok * QKVW + (g * 4 + hh) * 64 + d4);
            const unsigned lo = (unsigned)v, hi = (unsigned)(v >> 32);
            y0 += wg * __builtin_bit_cast(float, lo << 16); y1 += wg * __builtin_bit_cast(float, lo & 0xffff0000u); y2 += wg * __builtin_bit_cast(float, hi << 16); y3 += wg * __builtin_bit_cast(float, hi & 0xffff0000u); }
        const float iw = 1.0f / wsum;
        *(unsigned long long*)(F.YATTN + (size_t)tok * 256 + hh * 64 + d4) = (unsigned long long)pk2(y0 * iw, y1 * iw) | ((unsigned long long)pk2(y2 * iw, y3 * iw) << 32);
    }
}

__device__ __forceinline__ float log_sigmoid(float z) { return fminf(z, 0.f) - log1pf(__expf(-fabsf(z))); }
__device__ __forceinline__ void gla_decay_cumsum(Frame& F, LAS float* bq, LAS float* lrs, int tok0, int h, int dir) {
    const int tid = F.tid;
    const float* wl = dir ? F.w_lr_b : F.w_lr_f; const float* bl = dir ? F.b_lr_b : F.b_lr_f;
    for (int i = tid; i < 64 * 16; i += 512) lrs[i] = F.LR[(size_t)(tok0 + (i >> 4)) * 32 + dir * 16 + (i & 15)];
    __syncthreads();
    {
        const int d = tid & 63, cg = tid >> 6;
        float w[16];
#pragma unroll
        for (int r = 0; r < 16; ++r) w[r] = wl[r * 256 + h * 64 + d];
        const float bias = bl[h * 64 + d];
#pragma unroll
        for (int i = 0; i < 8; ++i) { const int c = cg * 8 + i; float z = bias;
#pragma unroll
            for (int r = 0; r < 16; ++r) z += lrs[c * 16 + r] * w[r];
            bq[c * 64 + d] = log_sigmoid(z) * (1.0f / 16.0f); }
    }
    __syncthreads();
    if (tid < 64) { float s = 0.f;
        if (dir == 0) { for (int c = 0; c < 64; ++c) { s += bq[c * 64 + tid]; bq[c * 64 + tid] = s; } }
        else { for (int c = 63; c >= 0; --c) { s += bq[c * 64 + tid]; bq[c * 64 + tid] = s; } } }
    __syncthreads();
}
__device__ __forceinline__ void gla_kv_simple(Frame& F) {
    LAS float* bq = (LAS float*)(F.lds);
    LAS float* kd = bq + 4096;
    LAS float* vs = kd + 4096;
    LAS float* lrs = vs + 8192;
    const int tid = F.tid;
    for (int u = F.vcu; u < 2048; u += F.G) {
        const int n = u & 31, dir = (u >> 5) & 1, h = (u >> 6) & 3, b = u >> 8;
        const int tok0 = b * SEQ + n * 64;
        gla_decay_cumsum(F, bq, lrs, tok0, h, dir);
        for (int i = tid; i < 4096; i += 512) { const int c = i >> 6, d = i & 63; const float bref = dir ? bq[d] : bq[63 * 64 + d];
            kd[i] = bf2f(F.GQK[(size_t)(tok0 + c) * 512 + 256 + h * 64 + d]) * __expf(bref - bq[i]); }
        for (int i = tid; i < 8192; i += 512) { const int c = i >> 7, v = i & 127; vs[i] = bf2f(F.GV[(size_t)(tok0 + c) * 512 + h * 128 + v]); }
        if (tid < 64) F.DEC[(size_t)u * 64 + tid] = __expf(dir ? bq[tid] : bq[63 * 64 + tid]);
        __syncthreads();
        {
            const int d = tid >> 3, vg = tid & 7; float acc[16];
#pragma unroll
            for (int i = 0; i < 16; ++i) acc[i] = 0.f;
            for (int c = 0; c < 64; ++c) { const float kk = kd[c * 64 + d];
#pragma unroll
                for (int i = 0; i < 16; ++i) acc[i] += kk * vs[c * 128 + vg * 16 + i]; }
            bf16* o = F.STATES + (size_t)u * 8192 + d * 128 + vg * 16;
#pragma unroll
            for (int i = 0; i < 16; i += 2) *(unsigned*)(o + i) = pk2(acc[i], acc[i + 1]);
        }
        __syncthreads();
    }
}
__device__ __forceinline__ void gla_scan_simple(Frame& F) {
    const int gt = F.vcu * 512 + F.tid, NGT = F.G * 512;
    for (int it = gt; it < 64 * 2048; it += NGT) {
        const int chain = it >> 11, e4 = it & 2047, d = (e4 * 4) >> 7, dir = chain & 1;
        unsigned long long kvw[32]; float dc[32];
#pragma unroll
        for (int k = 0; k < 32; ++k) { const int u = chain * 32 + (dir ? 31 - k : k); kvw[k] = *((const unsigned long long*)(F.STATES + (size_t)u * 8192) + e4); dc[k] = F.DEC[(size_t)u * 64 + d]; }
        float s0 = 0.f, s1 = 0.f, s2 = 0.f, s3 = 0.f;
#pragma unroll
        for (int k = 0; k < 32; ++k) { const int u = chain * 32 + (dir ? 31 - k : k);
            *((unsigned long long*)(F.STATES + (size_t)u * 8192) + e4) = (unsigned long long)pk2(s0, s1) | ((unsigned long long)pk2(s2, s3) << 32);
            const unsigned lo = (unsigned)kvw[k], hi = (unsigned)(kvw[k] >> 32);
            s0 = dc[k] * s0 + __builtin_bit_cast(float, lo << 16); s1 = dc[k] * s1 + __builtin_bit_cast(float, lo & 0xffff0000u);
            s2 = dc[k] * s2 + __builtin_bit_cast(float, hi << 16); s3 = dc[k] * s3 + __builtin_bit_cast(float, hi & 0xffff0000u); }
    }
}
__device__ __forceinline__ void gla_out_simple(Frame& F) {
    LAS float* bq = (LAS float*)(F.lds);
    LAS float* qi = bq + 4096;
    LAS float* ki = qi + 4096;
    LAS float* A  = ki + 4096;
    LAS float* vs = A + 4096;
    LAS float* Sp = vs + 8192;
    const int tid = F.tid;
    for (int u = F.vcu; u < 1024; u += F.G) {
        const int n = u & 31, h = (u >> 5) & 3, b = u >> 7;
        const int tok0 = b * SEQ + n * 64;
        const int c = tid >> 3, vg = tid & 7;
        float o[16];
#pragma unroll
        for (int i = 0; i < 16; ++i) o[i] = 0.f;
        for (int i = tid; i < 8192; i += 512) { const int cc = i >> 7, v = i & 127; vs[i] = bf2f(F.GV[(size_t)(tok0 + cc) * 512 + h * 128 + v]); }
#pragma unroll 1
        for (int dir = 0; dir < 2; ++dir) {
            gla_decay_cumsum(F, bq, Sp, tok0, h, dir);
            for (int i = tid; i < 4096; i += 512) { const int cc = i >> 6, d = i & 63; const float bb = bq[i];
                qi[i] = bf2f(F.GQK[(size_t)(tok0 + cc) * 512 + h * 64 + d]) * __expf(bb);
                ki[i] = bf2f(F.GQK[(size_t)(tok0 + cc) * 512 + 256 + h * 64 + d]) * __expf(-bb); }
            const size_t su = (size_t)(((b * 4 + h) * 2 + dir) * 32 + n) * 8192;
            for (int i = tid; i < 8192; i += 512) Sp[i] = bf2f(F.STATES[su + i]);
            __syncthreads();
            {
                float a[8];
#pragma unroll
                for (int i = 0; i < 8; ++i) a[i] = 0.f;
                for (int d = 0; d < 64; ++d) { const float q = qi[c * 64 + d];
#pragma unroll
                    for (int i = 0; i < 8; ++i) a[i] += q * ki[(vg * 8 + i) * 64 + d]; }
#pragma unroll
                for (int i = 0; i < 8; ++i) { const int s = vg * 8 + i; const bool keep = dir ? (s > c) : (s <= c); A[c * 64 + s] = keep ? a[i] : 0.f; }
            }
            __syncthreads();
            for (int s = 0; s < 64; ++s) { const float a = A[c * 64 + s], q = qi[c * 64 + s];
#pragma unroll
                for (int i = 0; i < 16; ++i) o[i] += a * vs[s * 128 + vg * 16 + i] + q * Sp[s * 128 + vg * 16 + i]; }
            __syncthreads();
        }
        float ss = 0.f;
#pragma unroll
        for (int i = 0; i < 16; ++i) ss += o[i] * o[i];
        ss += __shfl_xor(ss, 1); ss += __shfl_xor(ss, 2); ss += __shfl_xor(ss, 4);
        const float rstd = 1.0f / sqrtf(ss * (1.0f / 128.0f) + NORM_EPS);
        bf16* yo = F.GOUT + (size_t)(tok0 + c) * 512 + h * 128 + vg * 16;
#pragma unroll
        for (int i = 0; i < 16; i += 2) { const float g0 = F.gla_g[h * 128 + vg * 16 + i], g1 = F.gla_g[h * 128 + vg * 16 + i + 1];
            *(unsigned*)(yo + i) = pk2(o[i] * rstd * g0 * bf2f(yo[i]), o[i + 1] * rstd * g1 * bf2f(yo[i + 1])); }
    }
}


__device__ __forceinline__ void gla_decay(Frame& F, LAS float* lrs, LAS float* seg, int tok0, int h, int dir, float (&bc)[8], float& btot) {
    const int tid = F.tid, d = tid & 63, cg = tid >> 6;
    const float* wl = dir ? F.w_lr_b : F.w_lr_f; const float* bl = dir ? F.b_lr_b : F.b_lr_f;
#pragma unroll
    for (int i = 0; i < 2; ++i) { const int idx = tid + 512 * i; lrs[idx] = F.LR[(size_t)(tok0 + (idx >> 4)) * 32 + dir * 16 + (idx & 15)]; }
    float w[16];
#pragma unroll
    for (int r = 0; r < 16; ++r) w[r] = wl[r * 256 + h * 64 + d];
    const float bias = bl[h * 64 + d];
    __syncthreads();
    float la[8];
#pragma unroll
    for (int i = 0; i < 8; ++i) { const int c = cg * 8 + i; float z = bias;
#pragma unroll
        for (int r = 0; r < 16; ++r) z += lrs[c * 16 + r] * w[r];
        la[i] = log_sigmoid(z) * (1.0f / 16.0f); }
    if (dir == 0) { bc[0] = la[0];
#pragma unroll
        for (int i = 1; i < 8; ++i) bc[i] = bc[i - 1] + la[i];
        seg[cg * 64 + d] = bc[7]; }
    else { bc[7] = la[7];
#pragma unroll
        for (int i = 6; i >= 0; --i) bc[i] = bc[i + 1] + la[i];
        seg[cg * 64 + d] = bc[0]; }
    __syncthreads();
    float off = 0.f, tot = 0.f;
#pragma unroll
    for (int j = 0; j < 8; ++j) { const float t = seg[j * 64 + d]; tot += t; if (dir == 0 ? (j < cg) : (j > cg)) off += t; }
#pragma unroll
    for (int i = 0; i < 8; ++i) bc[i] += off;
    btot = tot;
}
__device__ __forceinline__ int vswz(int row) { return ((row & 3) << 2) | ((row >> 2) & 3); }
__device__ __forceinline__ void gla_stage_v(Frame& F, LAS unsigned char* Vs, int tok0, int h) {
#pragma unroll
    for (int i = 0; i < 2; ++i) { const int piece = F.wave * 2 + i, row = piece * 4 + (F.lane >> 4), chunk = (F.lane & 15) ^ vswz(row);
        __builtin_amdgcn_global_load_lds((const unsigned*)(F.GV + (size_t)(tok0 + row) * 512 + h * 128 + chunk * 8), (LAS unsigned*)(Vs + piece * 1024), 16, 0, 0); }
}
__device__ __forceinline__ v4i16_t gla_vtr(LAS const unsigned char* Vs, int r0, int vt, int lane) {
    const int row = r0 + ((lane & 15) >> 2), X = 2 * vt + ((lane & 3) >> 1);
    return lds_tr16(Vs + row * 256 + ((X ^ vswz(row)) << 4) + 8 * (lane & 1));
}
__device__ __forceinline__ void gla_kv_mfma(Frame& F) {
    LAS unsigned char* Vs = F.lds;
    LAS unsigned char* KdT = F.lds + 16384;
    LAS float* lrs = (LAS float*)(F.lds + 24576);
    LAS float* seg = (LAS float*)(F.lds + 28672);
    const int tid = F.tid, lane = F.lane, w = F.wave, l15 = lane & 15, g4 = lane >> 4, d = tid & 63, cg = tid >> 6;
    for (int u = F.vcu; u < 2048; u += F.G) {
        const int n = u & 31, dir = (u >> 5) & 1, h = (u >> 6) & 3, b = u >> 8;
        const int tok0 = b * SEQ + n * 64;
        gla_stage_v(F, Vs, tok0, h);
        float kx[8];
#pragma unroll
        for (int i = 0; i < 8; ++i) kx[i] = bf2f(F.GQK[(size_t)(tok0 + cg * 8 + i) * 512 + 256 + h * 64 + d]);
        float bc[8], btot;
        gla_decay(F, lrs, seg, tok0, h, dir, bc, btot);
        { v4u o;
          o.x = cvtpk(kx[0] * __expf(btot - bc[0]), kx[1] * __expf(btot - bc[1])); o.y = cvtpk(kx[2] * __expf(btot - bc[2]), kx[3] * __expf(btot - bc[3]));
          o.z = cvtpk(kx[4] * __expf(btot - bc[4]), kx[5] * __expf(btot - bc[5])); o.w = cvtpk(kx[6] * __expf(btot - bc[6]), kx[7] * __expf(btot - bc[7]));
          *(LAS v4u*)(KdT + d * 128 + ((cg ^ (d & 7)) << 4)) = o; }
        if (cg == 0) F.DEC[(size_t)u * 64 + d] = __expf(btot);
        asm volatile("s_waitcnt vmcnt(0)" ::: "memory");
        __syncthreads();
        f32x4 acc[4];
#pragma unroll
        for (int dt = 0; dt < 4; ++dt) acc[dt] = (f32x4){0.f, 0.f, 0.f, 0.f};
#pragma unroll
        for (int ks = 0; ks < 2; ++ks) {
            const v4i16_t va = gla_vtr(Vs, 32 * ks + 8 * g4, w, lane), vb = gla_vtr(Vs, 32 * ks + 8 * g4 + 4, w, lane);
            const bf16x8 vf = (bf16x8){va[0], va[1], va[2], va[3], vb[0], vb[1], vb[2], vb[3]};
#pragma unroll
            for (int dt = 0; dt < 4; ++dt) { const int dr = 16 * dt + l15;
                const bf16x8 kf = *(const LAS bf16x8*)(KdT + dr * 128 + (((4 * ks + g4) ^ (dr & 7)) << 4));
                acc[dt] = __builtin_amdgcn_mfma_f32_16x16x32_bf16(kf, vf, acc[dt], 0, 0, 0); }
        }
        bf16* so = F.STATES + (size_t)u * 8192 + (size_t)(16 * w + l15) * 64 + 4 * g4;
#pragma unroll
        for (int dt = 0; dt < 4; ++dt) *(unsigned long long*)(so + 16 * dt) = (unsigned long long)cvtpk(acc[dt][0], acc[dt][1]) | ((unsigned long long)cvtpk(acc[dt][2], acc[dt][3]) << 32);
        __syncthreads();
    }
}
__device__ __forceinline__ void gla_scan(Frame& F) {
    LAS float* dl = (LAS float*)F.lds;
    const int tid = F.tid;
    for (int blk = F.vcu; blk < 256; blk += F.G) {
        const int chain = blk >> 2, dir = chain & 1, e4 = (blk & 3) * 512 + tid, d0 = (e4 * 4) & 63;
#pragma unroll
        for (int i = 0; i < 4; ++i) { const int idx = tid + 512 * i, k = idx >> 6; dl[idx] = F.DEC[(size_t)(chain * 32 + (dir ? 31 - k : k)) * 64 + (idx & 63)]; }
        unsigned long long kvw[32];
#pragma unroll
        for (int k = 0; k < 32; ++k) { const int u = chain * 32 + (dir ? 31 - k : k); kvw[k] = *((const unsigned long long*)(F.STATES + (size_t)u * 8192) + e4); }
        __syncthreads();
        float s0 = 0.f, s1 = 0.f, s2 = 0.f, s3 = 0.f;
#pragma unroll
        for (int k = 0; k < 32; ++k) { const int u = chain * 32 + (dir ? 31 - k : k);
            *((unsigned long long*)(F.STATES + (size_t)u * 8192) + e4) = (unsigned long long)pk2(s0, s1) | ((unsigned long long)pk2(s2, s3) << 32);
            const f32x4 dc = *(const LAS f32x4*)(dl + k * 64 + d0);
            const unsigned lo = (unsigned)kvw[k], hi = (unsigned)(kvw[k] >> 32);
            s0 = dc[0] * s0 + __builtin_bit_cast(float, lo << 16); s1 = dc[1] * s1 + __builtin_bit_cast(float, lo & 0xffff0000u);
            s2 = dc[2] * s2 + __builtin_bit_cast(float, hi << 16); s3 = dc[3] * s3 + __builtin_bit_cast(float, hi & 0xffff0000u); }
        __syncthreads();
    }
}
__device__ __forceinline__ void gla_out_mfma(Frame& F) {
    LAS unsigned char* Vs = F.lds;
    LAS unsigned char* Qi = F.lds + 16384;
    LAS unsigned char* Ki = F.lds + 24576;
    LAS unsigned char* SpT = F.lds + 32768;
    LAS float* bq = (LAS float*)(F.lds + 49152);
    LAS float* lrs = (LAS float*)(F.lds + 65536);
    LAS float* seg = (LAS float*)(F.lds + 69632);
    LAS float* red = (LAS float*)(F.lds + 71680);
    const int tid = F.tid, lane = F.lane, w = F.wave, l15 = lane & 15, g4 = lane >> 4, d = tid & 63, cg = tid >> 6;
    const int ct = w & 3, vh = w >> 2, cc = tid >> 3, dg = tid & 7;
    for (int u = F.vcu; u < 1024; u += F.G) {
        const int n = u & 31, h = (u >> 5) & 3, b = u >> 7;
        const int tok0 = b * SEQ + n * 64;
        gla_stage_v(F, Vs, tok0, h);
        f32x4 o[4];
#pragma unroll
        for (int j = 0; j < 4; ++j) o[j] = (f32x4){0.f, 0.f, 0.f, 0.f};
#pragma unroll 1
        for (int dir = 0; dir < 2; ++dir) {
            const bf16* sp = F.STATES + (size_t)(((b * 4 + h) * 2 + dir) * 32 + n) * 8192;
#pragma unroll
            for (int i = 0; i < 2; ++i) { const int piece = w * 2 + i, row = piece * 8 + (lane >> 3), chunk = (lane & 7) ^ (lane >> 3);
                __builtin_amdgcn_global_load_lds((const unsigned*)(sp + (size_t)row * 64 + chunk * 8), (LAS unsigned*)(SpT + piece * 1024), 16, 0, 0); }
            const v4u qraw = *(const v4u*)(F.GQK + (size_t)(tok0 + cc) * 512 + h * 64 + dg * 8);
            const v4u kraw = *(const v4u*)(F.GQK + (size_t)(tok0 + cc) * 512 + 256 + h * 64 + dg * 8);
            float bc[8], btot;
            gla_decay(F, lrs, seg, tok0, h, dir, bc, btot);
#pragma unroll
            for (int i = 0; i < 8; ++i) bq[(cg * 8 + i) * 64 + d] = bc[i];
            __syncthreads();
            {
                const f32x4 b0 = *(const LAS f32x4*)(bq + cc * 64 + dg * 8), b1 = *(const LAS f32x4*)(bq + cc * 64 + dg * 8 + 4);
                const unsigned qw[4] = {qraw.x, qraw.y, qraw.z, qraw.w}, kw[4] = {kraw.x, kraw.y, kraw.z, kraw.w};
                const float bb[8] = {b0[0], b0[1], b0[2], b0[3], b1[0], b1[1], b1[2], b1[3]};
                unsigned qo[4], ko[4];
#pragma unroll
                for (int e = 0; e < 4; ++e) { const float e0 = __expf(bb[2 * e]), e1 = __expf(bb[2 * e + 1]);
                    qo[e] = cvtpk(__builtin_bit_cast(float, qw[e] << 16) * e0, __builtin_bit_cast(float, qw[e] & 0xffff0000u) * e1);
                    ko[e] = cvtpk(__builtin_bit_cast(float, kw[e] << 16) * __builtin_amdgcn_rcpf(e0), __builtin_bit_cast(float, kw[e] & 0xffff0000u) * __builtin_amdgcn_rcpf(e1)); }
                *(LAS v4u*)(Qi + cc * 128 + ((dg ^ (cc & 7)) << 4)) = (v4u){qo[0], qo[1], qo[2], qo[3]};
                *(LAS v4u*)(Ki + cc * 128 + ((dg ^ (cc & 7)) << 4)) = (v4u){ko[0], ko[1], ko[2], ko[3]};
            }
            asm volatile("s_waitcnt vmcnt(0)" ::: "memory");
            __syncthreads();
            bf16x8 qf[2];
#pragma unroll
            for (int ks = 0; ks < 2; ++ks) { const int cr = 16 * ct + l15; qf[ks] = *(const LAS bf16x8*)(Qi + cr * 128 + (((4 * ks + g4) ^ (cr & 7)) << 4)); }
            f32x4 a[4];
#pragma unroll
            for (int st = 0; st < 4; ++st) { a[st] = (f32x4){0.f, 0.f, 0.f, 0.f};
#pragma unroll
                for (int ks = 0; ks < 2; ++ks) { const int sr = 16 * st + l15;
                    const bf16x8 kf = *(const LAS bf16x8*)(Ki + sr * 128 + (((4 * ks + g4) ^ (sr & 7)) << 4));
                    a[st] = __builtin_amdgcn_mfma_f32_16x16x32_bf16(kf, qf[ks], a[st], 0, 0, 0); }
#pragma unroll
                for (int i = 0; i < 4; ++i) { const int s_ = 16 * st + 4 * g4 + i, c_ = 16 * ct + l15; const bool keep = dir ? (s_ > c_) : (s_ <= c_); a[st][i] = keep ? a[st][i] : 0.f; } }
#pragma unroll
            for (int ks = 0; ks < 2; ++ks) {
                v4u pw; pw.x = cvtpk(a[2 * ks][0], a[2 * ks][1]); pw.y = cvtpk(a[2 * ks][2], a[2 * ks][3]); pw.z = cvtpk(a[2 * ks + 1][0], a[2 * ks + 1][1]); pw.w = cvtpk(a[2 * ks + 1][2], a[2 * ks + 1][3]);
                const bf16x8 pf = __builtin_bit_cast(bf16x8, pw);
#pragma unroll
                for (int j = 0; j < 4; ++j) { const int vt = 4 * vh + j;
                    const v4i16_t va = gla_vtr(Vs, 32 * ks + 4 * g4, vt, lane), vb = gla_vtr(Vs, 32 * ks + 16 + 4 * g4, vt, lane);
                    const bf16x8 vf = (bf16x8){va[0], va[1], va[2], va[3], vb[0], vb[1], vb[2], vb[3]};
                    o[j] = __builtin_amdgcn_mfma_f32_16x16x32_bf16(vf, pf, o[j], 0, 0, 0); }
            }
#pragma unroll
            for (int ks = 0; ks < 2; ++ks)
#pragma unroll
                for (int j = 0; j < 4; ++j) { const int vr = 16 * (4 * vh + j) + l15;
                    const bf16x8 sf = *(const LAS bf16x8*)(SpT + vr * 128 + (((4 * ks + g4) ^ (vr & 7)) << 4));
                    o[j] = __builtin_amdgcn_mfma_f32_16x16x32_bf16(sf, qf[ks], o[j], 0, 0, 0); }
            __syncthreads();
        }
        float ss = 0.f;
#pragma unroll
        for (int j = 0; j < 4; ++j) ss += (o[j][0] * o[j][0] + o[j][1] * o[j][1]) + (o[j][2] * o[j][2] + o[j][3] * o[j][3]);
        ss += __shfl_xor(ss, 16); ss += __shfl_xor(ss, 32);
        if (g4 == 0) red[vh * 64 + 16 * ct + l15] = ss;
        __syncthreads();
        const float tot = red[16 * ct + l15] + red[64 + 16 * ct + l15];
        const float rstd = 1.0f / sqrtf(tot * (1.0f / 128.0f) + NORM_EPS);
        bf16* yo = F.GOUT + (size_t)(tok0 + 16 * ct + l15) * 512 + h * 128 + 4 * g4;
#pragma unroll
        for (int j = 0; j < 4; ++j) { const int v0 = 16 * (4 * vh + j);
            const unsigned long long gv = *(const unsigned long long*)(yo + v0);
            const f32x4 gg = *(const f32x4*)(F.gla_g + h * 128 + v0 + 4 * g4);
            const unsigned lo = (unsigned)gv, hi = (unsigned)(gv >> 32);
            const float y0 = o[j][0] * rstd * gg[0] * __builtin_bit_cast(float, lo << 16), y1 = o[j][1] * rstd * gg[1] * __builtin_bit_cast(float, lo & 0xffff0000u);
            const float y2 = o[j][2] * rstd * gg[2] * __builtin_bit_cast(float, hi << 16), y3 = o[j][3] * rstd * gg[3] * __builtin_bit_cast(float, hi & 0xffff0000u);
            *(unsigned long long*)(yo + v0) = (unsigned long long)cvtpk(y0, y1) | ((unsigned long long)cvtpk(y2, y3) << 32); }
        __syncthreads();
    }
}

struct Args { const float* in[19]; float* out; unsigned char* ws; int ph_lo, ph_hi, li, pad; };
__global__ void __launch_bounds__(NWAVES * 64, 2) fwd_megakernel(Args args) {
    extern __shared__ __attribute__((aligned(16))) unsigned char lds[];
    Frame F;
    F.lds = (LAS unsigned char*)lds;
    F.MISC = (volatile LAS unsigned*)(F.lds + MISC_OFF);
    F.tid = threadIdx.x; F.lane = F.tid & 63; F.wave = __builtin_amdgcn_readfirstlane(F.tid >> 6);
    F.G = gridDim.x; { const int bx = blockIdx.x; F.vcu = (F.G % 8 == 0) ? (bx % 8) * (F.G / 8) + bx / 8 : bx; }
    unsigned char* ws = args.ws;
    F.ctl = (gu32*)(ws + WS_CTL);
    F.x = args.in[0]; F.w_in = args.in[1]; F.rel_bias = args.in[2]; F.w_lr_f = args.in[3]; F.b_lr_f = args.in[4]; F.w_lr_b = args.in[5]; F.b_lr_b = args.in[6]; F.gla_g = args.in[7];
    F.w_ab = args.in[8]; F.w_gb = args.in[9]; F.w_out = args.in[10]; F.ln1_g = args.in[11]; F.ln1_b = args.in[12]; F.w_ff1 = args.in[13]; F.b_ff1 = args.in[14]; F.w_ff2 = args.in[15]; F.b_ff2 = args.in[16];
    F.ln2_g = args.in[17]; F.ln2_b = args.in[18]; F.out = args.out;
    F.WIN_t = (bf16*)(ws + WS_WIN); F.WAB_t = (bf16*)(ws + WS_WAB); F.WGB_t = (bf16*)(ws + WS_WGB); F.WOUT_t = (bf16*)(ws + WS_WOUT); F.WFF1_t = (bf16*)(ws + WS_WFF1); F.WFF2_t = (bf16*)(ws + WS_WFF2);
    F.XB = (bf16*)(ws + WS_XB); F.QKV = (bf16*)(ws + WS_QKV); F.GQK = (bf16*)(ws + WS_GQK); F.GV = (bf16*)(ws + WS_GV); F.GOUT = (bf16*)(ws + WS_GOUT); F.GATES = (bf16*)(ws + WS_GATES);
    F.YATTN = (bf16*)(ws + WS_YATTN); F.STATES = (bf16*)(ws + WS_STATES); F.MERGED = (bf16*)(ws + WS_MERGED); F.X1B = (bf16*)(ws + WS_X1B); F.HB = (bf16*)(ws + WS_H);
    F.LR = (float*)(ws + WS_LR); F.DEC = (float*)(ws + WS_DEC); F.PART = (float*)(ws + WS_PART); F.LSE = (float*)(ws + WS_LSE);
    for (int u = F.tid; u < (LDS_BYTES - LDSCTL_OFF) / 4; u += NWAVES * 64) ((LAS unsigned*)(F.lds + LDSCTL_OFF))[u] = 0u;
    __syncthreads();
    XcdBarrier bar; bar.bar = (unsigned*)(F.ctl + CW_BAR); bar.x = 0; bar.st = nullptr;
    if (!MK_PER_PHASE) bar = xcd_barrier_post((unsigned*)(F.ctl + CW_BAR), F.MISC + 8);
    const int lo = args.ph_lo, hi = args.ph_hi;
#define IN(k) (lo <= (k) && (k) < hi)
#define SEAM(k) do { if (IN(k) && IN((k) + 1)) xcd_barrier(bar); } while (0)

    if (IN(0)) { p0_prologue(F); } SEAM(0);
    if (IN(1)) {
        pg8::Gemm g{F.XB, F.WIN_t, M, NPROJ, D}; pg8::StaticOrder S; S.init(M, NPROJ, F.G, (int)blockIdx.x);
        pg8::EpiProj E{F.QKV, F.GQK, F.GV, F.GOUT, F.GATES, F.LR};
        pg8::gemm_phase<pg8::EpiProj, pg8::StaticOrder, true, true>(F.lds + RING_OFF, g, S, E);
    } SEAM(1);
    if (IN(2)) { attn_mfma(F); gla_kv_mfma(F); } SEAM(2);
    if (IN(3)) { gla_scan(F); attn_combine(F); } SEAM(3);
    if (IN(4)) { gla_out_mfma(F); } SEAM(4);
    if (IN(5)) {
        { pg8::Gemm g{F.YATTN, F.WAB_t, M, D, 256}; pg8::StaticOrder S; S.init(M, D, F.G, (int)blockIdx.x);
          pg8::EpiMerge<false> E{F.GATES, 0, F.PART, F.MERGED};
          pg8::gemm_phase<pg8::EpiMerge<false>, pg8::StaticOrder, true, true>(F.lds + RING_OFF, g, S, E); }
        { pg8::Gemm g{F.GOUT, F.WGB_t, M, D, 512}; pg8::StaticOrder S; S.init(M, D, F.G, (int)blockIdx.x);
          pg8::EpiMerge<true> E{F.GATES, 1024, F.PART, F.MERGED};
          pg8::gemm_phase<pg8::EpiMerge<true>, pg8::StaticOrder, true, true>(F.lds + RING_OFF, g, S, E); }
    } SEAM(5);
    if (IN(6)) {
        pg8::Gemm g{F.MERGED, F.WOUT_t, M, D, D}; pg8::StaticOrder S; S.init(M, D, F.G, (int)blockIdx.x);
        pg8::EpiResF32 E{F.x, F.out, nullptr, ALPHA};
        pg8::gemm_phase<pg8::EpiResF32, pg8::StaticOrder, true, true>(F.lds + RING_OFF, g, S, E);
    } SEAM(6);
    if (IN(7)) { ln_rows(F, F.out, F.ln1_g, F.ln1_b, F.X1B); } SEAM(7);
    if (IN(8)) {
        pg8::Gemm g{F.X1B, F.WFF1_t, M, FF, D}; pg8::StaticOrder S; S.init(M, FF, F.G, (int)blockIdx.x);
        pg8::EpiSqRelu E{F.HB, FF, F.b_ff1};
        pg8::gemm_phase<pg8::EpiSqRelu, pg8::StaticOrder, true, true>(F.lds + RING_OFF, g, S, E);
    } SEAM(8);
    if (IN(9)) {
        pg8::Gemm g{F.HB, F.WFF2_t, M, D, FF}; pg8::StaticOrder S; S.init(M, D, F.G, (int)blockIdx.x);
        pg8::EpiResF32 E{F.out, F.out, F.b_ff2, ALPHA};
        pg8::gemm_phase<pg8::EpiResF32, pg8::StaticOrder, true, true>(F.lds + RING_OFF, g, S, E);
    } SEAM(9);
    if (IN(10)) { ln_rows(F, F.out, F.ln2_g, F.ln2_b, nullptr); }
#undef IN
#undef SEAM
}

extern "C" void kernel_launch(void* const* d_in, const int* in_sizes, int n_in, void* d_out, int out_size, void* d_ws, size_t ws_size, hipStream_t stream) {
    static int grid = 0;
    if (grid == 0) {
        if (n_in != 19 || in_sizes[0] != M * D || out_size != M * D || ws_size < WS_END) { fprintf(stderr, "kernel_launch: unexpected shapes (n_in %d, in0 %d, out %d, ws %zu); nothing launched\n", n_in, n_in > 0 ? in_sizes[0] : -1, out_size, ws_size); grid = -1; return; }
        int dev = 0, cus = 0, per_cu = 0;
        if (hipGetDevice(&dev) != hipSuccess || hipDeviceGetAttribute(&cus, hipDeviceAttributeMultiprocessorCount, dev) != hipSuccess) { grid = -1; return; }
        if (hipFuncSetAttribute((const void*)fwd_megakernel, hipFuncAttributeMaxDynamicSharedMemorySize, LDS_BYTES) != hipSuccess) { fprintf(stderr, "kernel_launch: hipFuncSetAttribute failed\n"); grid = -1; return; }
        if (hipOccupancyMaxActiveBlocksPerMultiprocessor(&per_cu, (const void*)fwd_megakernel, NWAVES * 64, LDS_BYTES) != hipSuccess || per_cu < 1) { fprintf(stderr, "kernel_launch: occupancy query reports %d blocks per CU; nothing launched\n", per_cu); (void)hipGetLastError(); grid = -1; return; }
        grid = cus;
    }
    if (grid < 0) return;
    (void)hipMemsetAsync((char*)d_ws + WS_CTL, 0, CTL_ZERO_BYTES, stream);
    Args a{};
    for (int i = 0; i < 19; ++i) a.in[i] = (const float*)d_in[i];
    a.out = (float*)d_out; a.ws = (unsigned char*)d_ws;
#if MK_PER_PHASE
    for (int p = 0; p < NPH; ++p) { a.ph_lo = p; a.ph_hi = p + 1; a.li = p; hipLaunchKernelGGL(fwd_megakernel, dim3(grid), dim3(NWAVES * 64), LDS_BYTES, stream, a); }
#else
    a.ph_lo = 0; a.ph_hi = NPH; a.li = 0;
    hipLaunchKernelGGL(fwd_megakernel, dim3(grid), dim3(NWAVES * 64), LDS_BYTES, stream, a);
#endif
    const hipError_t le = hipPeekAtLastError();
    if (le != hipSuccess) fprintf(stderr, "kernel_launch: launch failed: %s\n", hipGetErrorName(le));
}
```
